# Optimizing an MI355X kernel written in HIP

```python
import jax, jax.numpy as jnp
from jax import lax
import numpy as np

D_MODEL = 1024
BATCH = 8
SEQ = 4096
DEPTH = 1

MEM_LEN = 256
HG_HEADS = 4
HG_KEY_DIM = 128
HG_VAL_DIM = 128
HG_KW = HG_HEADS * HG_KEY_DIM
HG_VW = HG_HEADS * HG_VAL_DIM
HG_CHUNK = 64
ATT_Q_HEADS = 8
ATT_KV_HEADS = 2
ATT_GROUP = ATT_Q_HEADS // ATT_KV_HEADS
ATT_HEAD_DIM = 64
ATT_QW = ATT_Q_HEADS * ATT_HEAD_DIM
ATT_KVW = ATT_KV_HEADS * ATT_HEAD_DIM
WINDOW = 128
ATT_BLOCK = 128
ROPE_THETA = 500000.0
ROT_DIM = ATT_HEAD_DIM // 4
MEM_HEADS = 4
MEM_HEAD_DIM = D_MODEL // MEM_HEADS
D_FF = 2816
CONV_WIDTH = 3
NORM_EPS = 1e-6
IN_SPLITS = (HG_KW, HG_KW, HG_KW, HG_VW, HG_VW, ATT_QW, ATT_KVW, ATT_KVW, D_MODEL, D_MODEL)
IN_COLS = sum(IN_SPLITS)
SPLIT_IDX = [int(c) for c in np.cumsum(IN_SPLITS)[:-1]]

kernel_name = 'hybrid_hgrn2_swa_memxattn_convffn_encoder'


def rms_norm(x, g):
    xf = x.astype(jnp.float32)
    y = xf * lax.rsqrt(jnp.mean(xf * xf, axis=-1, keepdims=True) + NORM_EPS) * g.astype(jnp.float32)
    return y.astype(x.dtype)


def partial_rotary(t, positions):
    half = ROT_DIM // 2
    inv_freq = 1.0 / (ROPE_THETA ** (jnp.arange(0, ROT_DIM, 2, dtype=jnp.float32) / ROT_DIM))
    ang = positions.astype(jnp.float32)[..., None] * inv_freq
    cos, sin = jnp.cos(ang)[:, :, None, :], jnp.sin(ang)[:, :, None, :]
    tf = t.astype(jnp.float32)
    t1, t2 = tf[..., :half], tf[..., half:ROT_DIM]
    out = jnp.concatenate([t1 * cos - t2 * sin, t2 * cos + t1 * sin, tf[..., ROT_DIM:]], axis=-1)
    return out.astype(t.dtype)


def gla_chunkwise(q, k, log_f, v):
    B, S, H, K = q.shape
    V = v.shape[-1]
    n_chunks = S // HG_CHUNK

    def chunks(t):
        return t.reshape(B, n_chunks, HG_CHUNK, H, t.shape[-1]).transpose(1, 0, 3, 2, 4)

    incl = jnp.tril(jnp.ones((HG_CHUNK, HG_CHUNK), dtype=bool))[:, :, None]

    def step(state, inp):
        qc, kc, gc, vc = inp
        b = jnp.cumsum(gc, axis=2)
        o_inter = jnp.einsum('bhtk,bhkv->bhtv', qc * jnp.exp(b), state)
        decay = jnp.exp(jnp.where(incl, b[:, :, :, None, :] - b[:, :, None, :, :], -jnp.inf))
        scores = jnp.einsum('bhtk,bhtsk->bhts', qc, decay * kc[:, :, None, :, :])
        o_intra = jnp.einsum('bhts,bhsv->bhtv', scores, vc)
        b_end = b[:, :, -1, :]
        new_state = (jnp.exp(b_end)[..., None] * state
                     + jnp.einsum('bhsk,bhsv->bhkv', kc * jnp.exp(b_end[:, :, None, :] - b), vc))
        return new_state, o_inter + o_intra

    state0 = jnp.zeros((B, H, K, V), jnp.float32)
    _, o = lax.scan(step, state0, (chunks(q), chunks(k), chunks(log_f), chunks(v)))
    return o.transpose(1, 0, 3, 2, 4).reshape(B, S, H, V)


def window_gqa_sink(q, k, v, sink):
    B, S = q.shape[0], q.shape[1]
    nb = S // ATT_BLOCK
    qb = q.reshape(B, nb, ATT_BLOCK, ATT_KV_HEADS, ATT_GROUP, ATT_HEAD_DIM)

    def band(t):
        tp = jnp.pad(t.reshape(B, nb, ATT_BLOCK, ATT_KV_HEADS, ATT_HEAD_DIM),
                     ((0, 0), (1, 1), (0, 0), (0, 0), (0, 0)))
        return jnp.concatenate([tp[:, :-2], tp[:, 1:-1], tp[:, 2:]], axis=2)

    kb, vb = band(k), band(v)
    s = jnp.einsum('bnqhgd,bnkhd->bnhgqk', qb, kb).astype(jnp.float32) * (ATT_HEAD_DIM ** -0.5)
    blk = jnp.arange(nb)[:, None, None]
    qi = blk * ATT_BLOCK + jnp.arange(ATT_BLOCK)[None, :, None]
    kj = (blk - 1) * ATT_BLOCK + jnp.arange(3 * ATT_BLOCK)[None, None, :]
    valid = (jnp.abs(qi - kj) <= WINDOW) & (kj >= 0) & (kj < S)
    s = jnp.where(valid[None, :, None, None], s, -jnp.inf)
    sk = sink.astype(jnp.float32).reshape(ATT_KV_HEADS, ATT_GROUP)[None, None, :, :, None, None]
    m = jnp.maximum(jnp.max(s, axis=-1, keepdims=True), sk)
    p = jnp.exp(s - m)
    p = p / (jnp.sum(p, axis=-1, keepdims=True) + jnp.exp(sk - m))
    o = jnp.einsum('bnhgqk,bnkhd->bnqhgd', p.astype(v.dtype), vb)
    return o.reshape(B, S, ATT_QW)


def token_mixers(n, positions, w_in, lb_fwd, lb_bwd, hg_norm, sink, w_br_rec, w_br_att, w_out):
    B, S, _ = n.shape
    f32 = jnp.float32
    proj = n @ w_in
    q_r, fz_f, fz_b, i_r, g_r, q_a, k_a, v_a, gate_r, gate_a = jnp.split(proj, SPLIT_IDX, axis=-1)

    qh = jax.nn.silu(q_r.astype(f32)).reshape(B, S, HG_HEADS, HG_KEY_DIM) * (HG_KEY_DIM ** -0.5)
    vh = i_r.astype(f32).reshape(B, S, HG_HEADS, HG_VAL_DIM)

    def forget(z, lb):
        f = lb + (1.0 - lb) * jax.nn.sigmoid(z.astype(f32))
        return ((1.0 - f).reshape(B, S, HG_HEADS, HG_KEY_DIM),
                jnp.log(f).reshape(B, S, HG_HEADS, HG_KEY_DIM))

    k_f, lf_f = forget(fz_f, lb_fwd)
    k_b, lf_b = forget(fz_b, lb_bwd)
    o_f = gla_chunkwise(qh, k_f, lf_f, vh)
    o_b = gla_chunkwise(qh[:, ::-1], k_b[:, ::-1], lf_b[:, ::-1], vh[:, ::-1])[:, ::-1]
    o = o_f + o_b
    o = (o * lax.rsqrt(jnp.mean(o * o, axis=-1, keepdims=True) + NORM_EPS)
         * hg_norm.astype(f32).reshape(HG_HEADS, HG_VAL_DIM))
    o = o.reshape(B, S, HG_VW) * jax.nn.silu(g_r.astype(f32))
    y_rec = o.astype(n.dtype) @ w_br_rec

    qa = partial_rotary(q_a.reshape(B, S, ATT_Q_HEADS, ATT_HEAD_DIM), positions)
    ka = partial_rotary(k_a.reshape(B, S, ATT_KV_HEADS, ATT_HEAD_DIM), positions)
    va = v_a.reshape(B, S, ATT_KV_HEADS, ATT_HEAD_DIM)
    y_att = window_gqa_sink(qa, ka, va, sink) @ w_br_att

    merged = jax.nn.sigmoid(gate_r) * y_rec + jax.nn.sigmoid(gate_a) * y_att
    return merged @ w_out


def memory_cross_attention(n, mem_n, w_q, w_kv, w_o):
    B, S, _ = n.shape
    M = mem_n.shape[1]
    q = (n @ w_q).reshape(B, S, MEM_HEADS, MEM_HEAD_DIM)
    k, v = jnp.split(mem_n @ w_kv, 2, axis=-1)
    k = k.reshape(B, M, MEM_HEADS, MEM_HEAD_DIM)
    v = v.reshape(B, M, MEM_HEADS, MEM_HEAD_DIM)
    s = jnp.einsum('bshd,bmhd->bhsm', q, k).astype(jnp.float32) * (MEM_HEAD_DIM ** -0.5)
    p = jax.nn.softmax(s, axis=-1).astype(v.dtype)
    o = jnp.einsum('bhsm,bmhd->bshd', p, v).reshape(B, S, D_MODEL)
    return o @ w_o


def conv_ffn(n, w_up, conv_w, conv_b, w_down):
    S = n.shape[1]
    u, g = jnp.split(n @ w_up, 2, axis=-1)
    pad = CONV_WIDTH // 2
    gp = jnp.pad(g, ((0, 0), (pad, pad), (0, 0)))
    gc = sum(gp[:, j:j + S] * conv_w[j] for j in range(CONV_WIDTH)) + conv_b
    return (jax.nn.silu(gc) * u) @ w_down


def setup_inputs(seed: int = 0) -> dict:
    key = jax.random.key(seed)
    ks = jax.random.split(key, 24)

    def nrm(k, shape, scale):
        return jax.random.normal(k, shape, jnp.float32) * scale

    def gain(k, shape):
        return 1.0 + 0.02 * jax.random.normal(k, shape, jnp.float32)

    L, D = DEPTH, D_MODEL
    return {
        'x': nrm(ks[0], (BATCH, SEQ, D), 1.0),
        'mem': nrm(ks[1], (BATCH, MEM_LEN, D), 1.0),
        'positions': jnp.broadcast_to(jnp.arange(SEQ, dtype=jnp.int32), (BATCH, SEQ)),
        'norm_mix': gain(ks[2], (L, D)),
        'w_in': nrm(ks[3], (L, D, IN_COLS), D ** -0.5),
        'lower_bounds': nrm(ks[4], (2, L + 1, HG_KW), 0.5),
        'hg_norm': gain(ks[5], (L, HG_VW)),
        'attn_sink': nrm(ks[6], (L, ATT_Q_HEADS), 0.5),
        'w_br_rec': nrm(ks[7], (L, HG_VW, D), HG_VW ** -0.5),
        'w_br_att': nrm(ks[8], (L, ATT_QW, D), ATT_QW ** -0.5),
        'w_mix_out': nrm(ks[9], (L, D, D), D ** -0.5),
        'norm_mem': gain(ks[10], (L, D)),
        'norm_mem_kv': gain(ks[11], (L, D)),
        'w_mem_q': nrm(ks[12], (L, D, D), D ** -0.5),
        'w_mem_kv': nrm(ks[13], (L, D, 2 * D), D ** -0.5),
        'w_mem_o': nrm(ks[14], (L, D, D), D ** -0.5),
        'norm_ffn': gain(ks[15], (L, D)),
        'w_up': nrm(ks[16], (L, D, 2 * D_FF), D ** -0.5),
        'conv_w': nrm(ks[17], (L, CONV_WIDTH, D_FF), CONV_WIDTH ** -0.5),
        'conv_b': nrm(ks[18], (L, D_FF), 0.01),
        'w_down': nrm(ks[19], (L, D_FF, D), D_FF ** -0.5),
        'final_norm': gain(ks[20], (D,)),
    }


def reference(x, mem, positions, norm_mix, w_in, lower_bounds, hg_norm, attn_sink, w_br_rec,
              w_br_att, w_mix_out, norm_mem, norm_mem_kv, w_mem_q, w_mem_kv, w_mem_o, norm_ffn,
              w_up, conv_w, conv_b, w_down, final_norm):
    lb_table = jnp.cumsum(jax.nn.softmax(lower_bounds.astype(jnp.float32), axis=1), axis=1)
    h = x
    for l in range(DEPTH):
        n = rms_norm(h, norm_mix[l])
        h = h + token_mixers(n, positions, w_in[l], lb_table[0, l], lb_table[1, l], hg_norm[l],
                             attn_sink[l], w_br_rec[l], w_br_att[l], w_mix_out[l])
        n = rms_norm(h, norm_mem[l])
        mem_n = rms_norm(mem, norm_mem_kv[l])
        h = h + memory_cross_attention(n, mem_n, w_mem_q[l], w_mem_kv[l], w_mem_o[l])
        n = rms_norm(h, norm_ffn[l])
        h = h + conv_ffn(n, w_up[l], conv_w[l], conv_b[l], w_down[l])
    return rms_norm(h, final_norm)
```

```cpp
#include <hip/hip_runtime.h>
#include <hip/hip_cooperative_groups.h>
#include <cstdio>
#include <cstring>
#include <cmath>
namespace cg = cooperative_groups;

#define LAS __attribute__((address_space(3)))
typedef unsigned short bf16_t;
typedef short bf16x8 __attribute__((ext_vector_type(8)));
typedef short s16x4 __attribute__((ext_vector_type(4)));
typedef float f32x4 __attribute__((ext_vector_type(4)));
typedef float f32x2 __attribute__((ext_vector_type(2)));
typedef unsigned u32x4 __attribute__((ext_vector_type(4)));
typedef unsigned u32x2 __attribute__((ext_vector_type(2)));
typedef _Float16 h16x4 __attribute__((ext_vector_type(4)));
typedef _Float16 h16x8 __attribute__((ext_vector_type(8)));

constexpr int T = 32768, SEQ = 4096;
constexpr size_t MiB = 1u << 20;
constexpr size_t O_WIN = 0;
constexpr size_t O_WMID = O_WIN + 5376ull * 1024 * 2;
constexpr size_t O_WOUT = O_WMID + 2 * MiB;
constexpr size_t O_WMQ = O_WOUT + 2 * MiB;
constexpr size_t O_WMKV = O_WMQ + 2 * MiB;
constexpr size_t O_WMO = O_WMKV + 4 * MiB;
constexpr size_t O_WUP = O_WMO + 2 * MiB;
constexpr size_t O_WDN = O_WUP + 11 * MiB;
constexpr size_t O_RSTD1 = 40 * MiB;
constexpr size_t O_SS2 = O_RSTD1 + 131072;
constexpr size_t O_SS3 = O_SS2 + 131072;
constexpr size_t O_SS4 = O_SS3 + 131072;
constexpr size_t O_RSTDM = O_SS4 + 131072;
constexpr size_t O_LBT = O_RSTDM + 8192;
constexpr size_t O_BAR = 40 * MiB + 768 * 1024;
constexpr size_t O_CS = 41 * MiB;
constexpr size_t O_KVM = 43 * MiB;
constexpr size_t O_MEMB = 51 * MiB;
constexpr size_t O_XB = 56 * MiB;
constexpr size_t O_OF = 56 * MiB, O_OB = 88 * MiB;
constexpr size_t O_QH = 120 * MiB, O_KKF = 152 * MiB, O_KKB = 184 * MiB, O_VH = 216 * MiB, O_SG = 248 * MiB;
constexpr size_t O_QA = 280 * MiB, O_KA = 312 * MiB, O_VA = 320 * MiB;
constexpr size_t O_OA = 328 * MiB;
constexpr size_t O_MERGED = 392 * MiB;
constexpr size_t O_QB = 392 * MiB, O_SMID = 424 * MiB;
constexpr size_t O_HB1 = 120 * MiB, O_QM = 184 * MiB, O_OM = 248 * MiB, O_HB2 = 56 * MiB;
constexpr size_t O_U = 120 * MiB, O_G = 296 * MiB;
constexpr size_t O_SSP2 = 472 * MiB, O_SSP3 = 474 * MiB, O_SSP4 = 476 * MiB;
constexpr size_t O_HB3 = 296 * MiB;

__device__ __forceinline__ float bf2f(unsigned short b) { return __uint_as_float(((unsigned)b) << 16); }
__device__ __forceinline__ float bflo(unsigned w) { return __uint_as_float(w << 16); }
__device__ __forceinline__ float bfhi(unsigned w) { return __uint_as_float(w & 0xffff0000u); }
typedef __bf16 bf16x2_t __attribute__((ext_vector_type(2)));
__device__ __forceinline__ unsigned cvt_pk_bf16(float lo, float hi) { const f32x2 v = {lo, hi}; return __builtin_bit_cast(unsigned, __builtin_convertvector(v, bf16x2_t)); }
__device__ __forceinline__ float sigmoidf_(float x) { return __builtin_amdgcn_rcpf(1.0f + __expf(-x)); }
__device__ __forceinline__ u32x2 pack4(f32x4 v) { u32x2 w; w.x = cvt_pk_bf16(v[0], v[1]); w.y = cvt_pk_bf16(v[2], v[3]); return w; }

struct TJob { const float* src; const float* gain; unsigned long long dst_off; int K, N, ldo, koff; float scale; int tile0; };

struct Params {
    const float* x; const float* mem; const int* positions; const float* lower_bounds; const float* hg_norm; const float* sink;
    const float* conv_w; const float* conv_b; const float* final_norm;
    float* out; unsigned char* ws;
    double inv_freq[8];
    TJob jobs[9];
    int njobs; int ntiles;
};

namespace pg8 {
constexpr int BM = 256, BK = 64, HALF = 128, HTB = HALF * BK * 2, STAGE_BYTES = 8 * HTB, NXCD = 8, WGM = 8;
__host__ __device__ __forceinline__ int lds_byte(int r, int c) { const int st = (r >> 4) * 2 + (c >> 5), rr = r & 15, cc = c & 31, ob = rr * 64 + cc * 2; return st * 1024 + (ob ^ (((ob >> 9) & 1) << 5)); }
__host__ __device__ __forceinline__ void stage_rc(int b, int& R, int& C) { const int st = b / 1024, sb = b % 1024, swz = sb ^ (((sb >> 9) & 1) << 5); R = (st >> 1) * 16 + swz / 64; C = (st & 1) * 32 + (swz % 64) / 2; }
__host__ __device__ __forceinline__ int perm32(int rho) { const int n = rho >> 4, i = rho & 15; return 8 * (i >> 2) + 4 * n + (i & 3); }
struct Unit { int pm, pn; };
struct Gemm { const bf16_t* A; const bf16_t* Bt; int M, N, K, lda, ldb; };
struct StaticOrder {
    int nM, nN, nwg, G, c;
    __host__ __device__ void init(int M, int N, int G_, int c_) { nM = M / BM; nN = N / BM; nwg = nM * nN; G = G_; c = c_; }
    __host__ __device__ bool next(int i, Unit& u) const {
        const long L = (long)i * G + c; if (L >= nwg) return false;
        int wgid = (int)L; { const int q = nwg / NXCD, r = nwg % NXCD, xcd = wgid % NXCD, off = wgid / NXCD; wgid = (xcd < r ? xcd * (q + 1) : r * (q + 1) + (xcd - r) * q) + off; }
        const int nig = WGM * nN, gid = wgid / nig, fm = gid * WGM, gsz = (nM - fm) < WGM ? (nM - fm) : WGM;
        u.pm = fm + ((wgid % nig) % gsz); u.pn = (wgid % nig) / gsz; return true;
    }
    __device__ __forceinline__ void a_ready(const Unit&) const {}
    __device__ __forceinline__ void done(const Unit&) const {}
};

template <class Epi, class Sched>
__device__ __forceinline__ void gemm_phase(LAS unsigned char* lds, const Gemm g, const Sched& S, const Epi& E) {
    int tid = threadIdx.x; asm volatile("" : "+v"(tid));
    const int wid = __builtin_amdgcn_readfirstlane(tid >> 6), lane = tid & 63, wr = wid >> 2, wc = wid & 3, fr = lane & 15, fq = lane >> 4;
    const int K = g.K, nt = K / BK;
    unsigned voffA[2], voffB[2];
#pragma unroll
    for (int i = 0; i < 2; ++i) { int R, C; stage_rc(tid * 16 + i * 8192, R, C); const int Rb = Epi::PERM ? ((R & ~31) + perm32(R & 31)) : R;
        voffA[i] = (unsigned)(R * g.lda + C) * 2u; voffB[i] = (unsigned)(Rb * g.ldb + C) * 2u; }
    const size_t kstep = (size_t)(BK * 2);
    const size_t hstepA = (size_t)HALF * g.lda * 2, hstepB = (size_t)HALF * g.ldb * 2;
    const size_t tstepA = 2 * hstepA, tstepB = 2 * hstepB;
    const unsigned ldsw = (unsigned)wid * 1024u;
    const int aoff = lds_byte(wr * 64 + fr, fq * 8), boff = lds_byte(wc * 32 + fr, fq * 8);
#define PG8_SA(b, h) (((b) * 2 + (h)) * HTB)
#define PG8_SB(b, h) ((4 + (b) * 2 + (h)) * HTB)
#define PG8_STAGE(bufoff, gbase, voff) do { _Pragma("unroll") for (int _i = 0; _i < 2; ++_i) \
        __builtin_amdgcn_global_load_lds((const unsigned*)((const char*)(gbase) + (voff)[_i]), (LAS unsigned*)(lds + (bufoff) + ldsw + _i * 8192), 16, 0, 0); } while (0)
#define PG8_LDA(dst, b, h) do { _Pragma("unroll") for (int m = 0; m < 4; ++m) _Pragma("unroll") for (int k = 0; k < 2; ++k) dst[m][k] = *(const LAS bf16x8*)(lds + PG8_SA(b, h) + aoff + m * 2048 + k * 1024); } while (0)
#define PG8_LDB(dst, b, h) do { _Pragma("unroll") for (int n = 0; n < 2; ++n) _Pragma("unroll") for (int k = 0; k < 2; ++k) dst[n][k] = *(const LAS bf16x8*)(lds + PG8_SB(b, h) + boff + n * 2048 + k * 1024); } while (0)
#define PG8_MMA(ai, bj, At, Bt) do { __builtin_amdgcn_s_setprio(1); _Pragma("unroll") for (int m = 0; m < 4; ++m) _Pragma("unroll") for (int n = 0; n < 2; ++n) _Pragma("unroll") for (int k = 0; k < 2; ++k) \
        acc[ai][bj][m][n] = __builtin_amdgcn_mfma_f32_16x16x32_bf16(Bt[n][k], At[m][k], acc[ai][bj][m][n], 0, 0, 0); __builtin_amdgcn_s_setprio(0); } while (0)
#define PG8_WAIT_V(n) asm volatile("s_waitcnt vmcnt(" #n ")" ::: "memory")
#define PG8_WAIT_L(n) asm volatile("s_waitcnt lgkmcnt(" #n ")" ::: "memory")
#define PG8_BAR __builtin_amdgcn_s_barrier()
#define PG8_SCHED __builtin_amdgcn_sched_barrier(0)
    Unit cur, nxt; int ui = 0;
    if (!S.next(0, cur)) return;
    f32x4 acc[2][2][4][2];
#pragma unroll
    for (int a = 0; a < 2; ++a)
#pragma unroll
        for (int b = 0; b < 2; ++b)
#pragma unroll
            for (int m = 0; m < 4; ++m)
#pragma unroll
                for (int n = 0; n < 2; ++n) acc[a][b][m][n] = (f32x4){0.f, 0.f, 0.f, 0.f};
    bf16x8 At[4][2], B0[2][2], B1[2][2];
    const char* cA = (const char*)g.A + (size_t)cur.pm * tstepA; const char* cB = (const char*)g.Bt + (size_t)cur.pn * tstepB;
    S.a_ready(cur);
    PG8_STAGE(PG8_SB(0, 0), cB, voffB); PG8_STAGE(PG8_SA(0, 0), cA, voffA); PG8_STAGE(PG8_SB(0, 1), cB + hstepB, voffB); PG8_STAGE(PG8_SA(0, 1), cA + hstepA, voffA);
    if (wr == 1) PG8_BAR;
    PG8_WAIT_V(4); PG8_BAR;
    PG8_STAGE(PG8_SB(1, 0), cB + kstep, voffB); PG8_STAGE(PG8_SA(1, 0), cA + kstep, voffA); PG8_STAGE(PG8_SB(1, 1), cB + hstepB + kstep, voffB);
    PG8_WAIT_V(6); PG8_BAR;
    for (;;) {
        const bool has_next = S.next(ui + 1, nxt);
        const char* nA = has_next ? (const char*)g.A + (size_t)nxt.pm * tstepA : cA; const char* nB = has_next ? (const char*)g.Bt + (size_t)nxt.pn * tstepB : cB;
        for (int t = 0; t < nt; t += 2) {
            const bool last = (t == nt - 2);
            if constexpr (Epi::HAS_MID) { if (t == nt / 2) E.mid(acc, cur, wr, wc, fr, fq); }
            const char* a1 = cA + (size_t)(t + 1) * kstep;
            const char* a2 = last ? nA : cA + (size_t)(t + 2) * kstep; const char* b2 = last ? nB : cB + (size_t)(t + 2) * kstep;
            const char* a3 = a2 + kstep; const char* b3 = b2 + kstep;
            if (last && has_next) S.a_ready(nxt);
            PG8_LDB(B0, 0, 0); PG8_SCHED; PG8_LDA(At, 0, 0); PG8_STAGE(PG8_SA(1, 1), a1 + hstepA, voffA);
            PG8_WAIT_L(8); PG8_BAR; PG8_WAIT_L(0); PG8_MMA(0, 0, At, B0); PG8_BAR; PG8_SCHED;
            PG8_LDB(B1, 0, 1); PG8_STAGE(PG8_SB(0, 0), b2, voffB);
            PG8_BAR; PG8_WAIT_L(0); PG8_MMA(0, 1, At, B1); PG8_BAR;
            PG8_LDA(At, 0, 1); PG8_STAGE(PG8_SA(0, 0), a2, voffA);
            PG8_BAR; PG8_WAIT_L(0); PG8_MMA(1, 0, At, B0); PG8_BAR; PG8_SCHED;
            PG8_STAGE(PG8_SB(0, 1), b2 + hstepB, voffB);
            PG8_WAIT_V(6); PG8_BAR; PG8_MMA(1, 1, At, B1); PG8_BAR;
            PG8_LDB(B0, 1, 0); PG8_SCHED; PG8_LDA(At, 1, 0); PG8_STAGE(PG8_SA(0, 1), a2 + hstepA, voffA);
            PG8_WAIT_L(8); PG8_BAR; PG8_WAIT_L(0); PG8_MMA(0, 0, At, B0); PG8_BAR; PG8_SCHED;
            PG8_LDB(B1, 1, 1); PG8_STAGE(PG8_SB(1, 0), b3, voffB);
            PG8_BAR; PG8_WAIT_L(0); PG8_MMA(0, 1, At, B1); PG8_BAR;
            PG8_LDA(At, 1, 1); PG8_STAGE(PG8_SA(1, 0), a3, voffA);
            PG8_BAR; PG8_WAIT_L(0); PG8_MMA(1, 0, At, B0); PG8_BAR; PG8_SCHED;
            PG8_STAGE(PG8_SB(1, 1), b3 + hstepB, voffB);
            PG8_WAIT_V(6); PG8_BAR; PG8_MMA(1, 1, At, B1); PG8_BAR;
        }
        E(acc, cur, wr, wc, fr, fq); S.done(cur);
        if (!has_next) break;
#pragma unroll
        for (int a = 0; a < 2; ++a)
#pragma unroll
            for (int b = 0; b < 2; ++b)
#pragma unroll
                for (int m = 0; m < 4; ++m)
#pragma unroll
                    for (int n = 0; n < 2; ++n) acc[a][b][m][n] = (f32x4){0.f, 0.f, 0.f, 0.f};
        cur = nxt; cA = nA; cB = nB; ++ui;
    }
    PG8_WAIT_V(0);
    if (wr == 0) PG8_BAR;
    PG8_BAR;
#undef PG8_SA
#undef PG8_SB
#undef PG8_STAGE
#undef PG8_LDA
#undef PG8_LDB
#undef PG8_MMA
#undef PG8_WAIT_V
#undef PG8_WAIT_L
#undef PG8_BAR
#undef PG8_SCHED
}
}

#define EPI_LOOP_ROWS _Pragma("unroll") for (int ai = 0; ai < 2; ++ai) _Pragma("unroll") for (int m = 0; m < 4; ++m)
#define EPI_LOOP_COLS _Pragma("unroll") for (int bj = 0; bj < 2; ++bj) _Pragma("unroll") for (int n = 0; n < 2; ++n)

struct EpiProj {
    static constexpr bool PERM = true, HAS_MID = false;
    const float* rstd; const float* lbt; const float* cs;
    bf16_t *QH, *VH, *SG, *QA, *KA, *VA, *GR, *GA; _Float16 *KKF, *KKB;
    template <int MODE>
    __device__ __forceinline__ void run(const f32x4 (&acc)[2][2][4][2], const pg8::Unit& u, int wr, int wc, int fr, int fq) const {
        const int pn = u.pn;
        EPI_LOOP_ROWS {
            const int row = u.pm * 256 + ai * 128 + wr * 64 + m * 16 + fr;
#pragma unroll
            for (int bj = 0; bj < 2; ++bj) {
                const int col = pn * 256 + bj * 128 + wc * 32 + 8 * fq;
                f32x4 v0 = acc[ai][bj][m][0], v1 = acc[ai][bj][m][1];
                if (MODE == 0) {
#pragma unroll
                    for (int i = 0; i < 4; ++i) { v0[i] = v0[i] * sigmoidf_(v0[i]) * 0.08838834764831845f; v1[i] = v1[i] * sigmoidf_(v1[i]) * 0.08838834764831845f; }
                    const u32x2 lo = pack4(v0), hi = pack4(v1);
                    *(u32x4*)(QH + (size_t)row * 512 + col) = (u32x4){lo.x, lo.y, hi.x, hi.y};
                } else if (MODE == 1 || MODE == 2) {
                    const int c = col - (MODE == 1 ? 512 : 1024);
                    const f32x4 lb0 = *(const f32x4*)(lbt + (MODE == 1 ? 0 : 512) + c), lb1 = *(const f32x4*)(lbt + (MODE == 1 ? 0 : 512) + c + 4);
                    h16x8 o;
#pragma unroll
                    for (int i = 0; i < 4; ++i) {
                        o[i] = (_Float16)__log2f(1.0f - (1.0f - lb0[i]) * __builtin_amdgcn_rcpf(1.0f + __expf(v0[i])));
                        o[4 + i] = (_Float16)__log2f(1.0f - (1.0f - lb1[i]) * __builtin_amdgcn_rcpf(1.0f + __expf(v1[i])));
                    }
                    *(h16x8*)((MODE == 1 ? KKF : KKB) + (size_t)row * 512 + c) = o;
                } else if (MODE == 3) {
                    const u32x2 lo = pack4(v0), hi = pack4(v1);
                    *(u32x4*)(VH + (size_t)row * 512 + (col - 1536)) = (u32x4){lo.x, lo.y, hi.x, hi.y};
                } else if (MODE == 4) {
#pragma unroll
                    for (int i = 0; i < 4; ++i) { v0[i] = v0[i] * sigmoidf_(v0[i]); v1[i] = v1[i] * sigmoidf_(v1[i]); }
                    const u32x2 lo = pack4(v0), hi = pack4(v1);
                    *(u32x4*)(SG + (size_t)row * 512 + (col - 2048)) = (u32x4){lo.x, lo.y, hi.x, hi.y};
                } else if (MODE == 5 || MODE == 6) {
                    const bool rot = ((wc & 1) == 0) && (MODE == 5 || bj == 0);
                    if (rot) {
                        f32x4 p0, p1;
#pragma unroll
                        for (int i = 0; i < 4; ++i) { p0[i] = __shfl_xor(v0[i], 16); p1[i] = __shfl_xor(v1[i], 16); }
                        const f32x4 c0 = *(const f32x4*)(cs + (size_t)row * 16), c1 = *(const f32x4*)(cs + (size_t)row * 16 + 4);
                        const f32x4 s0 = *(const f32x4*)(cs + (size_t)row * 16 + 8), s1 = *(const f32x4*)(cs + (size_t)row * 16 + 12);
                        const f32x4 r0a = v0 * c0 - p0 * s0, r1a = v1 * c1 - p1 * s1, r0b = v0 * c0 + p0 * s0, r1b = v1 * c1 + p1 * s1;
                        v0 = (fq == 0) ? r0a : ((fq == 1) ? r0b : v0); v1 = (fq == 0) ? r1a : ((fq == 1) ? r1b : v1);
                    }
                    if (MODE == 5) { v0 = v0 * 0.125f; v1 = v1 * 0.125f; }
                    const u32x2 lo = pack4(v0), hi = pack4(v1); const u32x4 w = (u32x4){lo.x, lo.y, hi.x, hi.y};
                    if (MODE == 5) *(u32x4*)(QA + (size_t)row * 512 + (col - 2560)) = w;
                    else if (bj == 0) *(u32x4*)(KA + (size_t)row * 128 + (col - 3072)) = w;
                    else *(u32x4*)(VA + (size_t)row * 128 + (col - 3200)) = w;
                } else {
#pragma unroll
                    for (int i = 0; i < 4; ++i) { v0[i] = sigmoidf_(v0[i]); v1[i] = sigmoidf_(v1[i]); }
                    const u32x2 lo = pack4(v0), hi = pack4(v1); const u32x4 w = (u32x4){lo.x, lo.y, hi.x, hi.y};
                    if (MODE == 7) *(u32x4*)(GR + (size_t)row * 1024 + (col - 3328)) = w;
                    else *(u32x4*)(GA + (size_t)row * 1024 + (col - 4352)) = w;
                }
            }
        }
    }
    __device__ __forceinline__ void operator()(const f32x4 (&acc)[2][2][4][2], const pg8::Unit& u, int wr, int wc, int fr, int fq) const {
        const int pn = u.pn;
        if (pn < 2) run<0>(acc, u, wr, wc, fr, fq);
        else if (pn < 4) run<1>(acc, u, wr, wc, fr, fq);
        else if (pn < 6) run<2>(acc, u, wr, wc, fr, fq);
        else if (pn < 8) run<3>(acc, u, wr, wc, fr, fq);
        else if (pn < 10) run<4>(acc, u, wr, wc, fr, fq);
        else if (pn < 12) run<5>(acc, u, wr, wc, fr, fq);
        else if (pn == 12) run<6>(acc, u, wr, wc, fr, fq);
        else if (pn < 17) run<7>(acc, u, wr, wc, fr, fq);
        else run<8>(acc, u, wr, wc, fr, fq);
    }
};

__device__ __forceinline__ void epi_membar() { asm volatile("" ::: "memory"); }
template <int MODE>
struct EpiScale {
    static constexpr bool PERM = (MODE != 0), HAS_MID = false;
    const float* rs; bf16_t* O; int ldo; bf16_t* O2; int split;
    __device__ __forceinline__ void operator()(const f32x4 (&acc)[2][2][4][2], const pg8::Unit& u, int wr, int wc, int fr, int fq) const {
        bf16_t* base = O; int cb = u.pn * 256;
        if (cb >= split) { base = O2; cb -= split; }
        EPI_LOOP_ROWS {
            const int row = u.pm * 256 + ai * 128 + wr * 64 + m * 16 + fr;
            float s;
            if (MODE == 0) s = rs[row];
            else if (MODE == 2) s = 1.0f;
            else { const f32x4* q = (const f32x4*)(rs + (size_t)row * 16); const f32x4 t = (q[0] + q[1]) + (q[2] + q[3]); s = rsqrtf(((t[0] + t[1]) + (t[2] + t[3])) * (1.0f / 1024.0f) + 1e-6f); }
            if constexpr (PERM) {
#pragma unroll
                for (int bj = 0; bj < 2; ++bj) {
                    const int col = cb + bj * 128 + wc * 32 + 8 * fq;
                    const u32x2 lo = pack4(acc[ai][bj][m][0] * s), hi = pack4(acc[ai][bj][m][1] * s);
                    *(u32x4*)(base + (size_t)row * ldo + col) = (u32x4){lo.x, lo.y, hi.x, hi.y};
                }
                epi_membar();
            } else {
                EPI_LOOP_COLS {
                    const int col = cb + bj * 128 + wc * 32 + n * 16 + 4 * fq;
                    *(u32x2*)(base + (size_t)row * ldo + col) = pack4(acc[ai][bj][m][n] * s);
                }
            }
        }
    }
};

struct EpiMergeFused {
    static constexpr bool PERM = true, HAS_MID = true;
    const bf16_t* GR; const bf16_t* GA; bf16_t* O;
    __device__ __forceinline__ void mid(f32x4 (&acc)[2][2][4][2], const pg8::Unit& u, int wr, int wc, int fr, int fq) const {
        asm volatile("" : "+v"(fr), "+v"(fq));
#pragma unroll
        for (int ai = 0; ai < 2; ++ai)
#pragma unroll
            for (int m = 0; m < 4; ++m) {
                const int row = u.pm * 256 + ai * 128 + wr * 64 + m * 16 + fr;
#pragma unroll
                for (int bj = 0; bj < 2; ++bj) {
                    const int col = u.pn * 256 + bj * 128 + wc * 32 + 8 * fq;
                    const u32x4 r = *(const u32x4*)(GR + (size_t)row * 1024 + col), a = *(const u32x4*)(GA + (size_t)row * 1024 + col);
                    f32x4 f0, f1;
                    f0[0] = bflo(r.x) * __builtin_amdgcn_rcpf(fmaxf(bflo(a.x), 1e-30f)); f0[1] = bfhi(r.x) * __builtin_amdgcn_rcpf(fmaxf(bfhi(a.x), 1e-30f));
                    f0[2] = bflo(r.y) * __builtin_amdgcn_rcpf(fmaxf(bflo(a.y), 1e-30f)); f0[3] = bfhi(r.y) * __builtin_amdgcn_rcpf(fmaxf(bfhi(a.y), 1e-30f));
                    f1[0] = bflo(r.z) * __builtin_amdgcn_rcpf(fmaxf(bflo(a.z), 1e-30f)); f1[1] = bfhi(r.z) * __builtin_amdgcn_rcpf(fmaxf(bfhi(a.z), 1e-30f));
                    f1[2] = bflo(r.w) * __builtin_amdgcn_rcpf(fmaxf(bflo(a.w), 1e-30f)); f1[3] = bfhi(r.w) * __builtin_amdgcn_rcpf(fmaxf(bfhi(a.w), 1e-30f));
                    acc[ai][bj][m][0] = acc[ai][bj][m][0] * f0; acc[ai][bj][m][1] = acc[ai][bj][m][1] * f1;
                }
                if (m == 3) epi_membar();
            }
    }
    __device__ __forceinline__ void operator()(const f32x4 (&acc)[2][2][4][2], const pg8::Unit& u, int wr, int wc, int fr, int fq) const {
        EPI_LOOP_ROWS {
            const int row = u.pm * 256 + ai * 128 + wr * 64 + m * 16 + fr;
#pragma unroll
            for (int bj = 0; bj < 2; ++bj) {
                const int col = u.pn * 256 + bj * 128 + wc * 32 + 8 * fq;
                const u32x4 a = *(const u32x4*)(GA + (size_t)row * 1024 + col);
                f32x4 f0, f1; f0[0] = bflo(a.x); f0[1] = bfhi(a.x); f0[2] = bflo(a.y); f0[3] = bfhi(a.y); f1[0] = bflo(a.z); f1[1] = bfhi(a.z); f1[2] = bflo(a.w); f1[3] = bfhi(a.w);
                const u32x2 lo = pack4(acc[ai][bj][m][0] * f0), hi = pack4(acc[ai][bj][m][1] * f1);
                *(u32x4*)(O + (size_t)row * 1024 + col) = (u32x4){lo.x, lo.y, hi.x, hi.y};
            }
        }
    }
};

template <int BASE_BF16>
struct EpiRes {
    static constexpr bool PERM = true, HAS_MID = false;
    const void* base; bf16_t* HB; float* ssp;
    __device__ __forceinline__ void operator()(const f32x4 (&acc)[2][2][4][2], const pg8::Unit& u, int wr, int wc, int fr, int fq) const {
        EPI_LOOP_ROWS {
            const int row = u.pm * 256 + ai * 128 + wr * 64 + m * 16 + fr;
            float sq = 0.f;
#pragma unroll
            for (int bj = 0; bj < 2; ++bj) {
                const int col = u.pn * 256 + bj * 128 + wc * 32 + 8 * fq;
                f32x4 h0, h1;
                if (BASE_BF16) { const u32x4 b = *(const u32x4*)((const bf16_t*)base + (size_t)row * 1024 + col);
                    h0[0] = bflo(b.x); h0[1] = bfhi(b.x); h0[2] = bflo(b.y); h0[3] = bfhi(b.y); h1[0] = bflo(b.z); h1[1] = bfhi(b.z); h1[2] = bflo(b.w); h1[3] = bfhi(b.w); }
                else { h0 = *(const f32x4*)((const float*)base + (size_t)row * 1024 + col); h1 = *(const f32x4*)((const float*)base + (size_t)row * 1024 + col + 4); }
                h0 = h0 + acc[ai][bj][m][0]; h1 = h1 + acc[ai][bj][m][1];
                const u32x2 lo = pack4(h0), hi = pack4(h1);
                *(u32x4*)(HB + (size_t)row * 1024 + col) = (u32x4){lo.x, lo.y, hi.x, hi.y};
                sq += (h0[0] * h0[0] + h0[1] * h0[1] + h0[2] * h0[2] + h0[3] * h0[3]) + (h1[0] * h1[0] + h1[1] * h1[1] + h1[2] * h1[2] + h1[3] * h1[3]);
            }
            sq += __shfl_xor(sq, 16); sq += __shfl_xor(sq, 32);
            if (fq == 0) ssp[(size_t)row * 16 + u.pn * 4 + wc] = sq;
        }
    }
};

__device__ __forceinline__ void rownorm_bf16_x2(const float* H, bf16_t* HB, int row, int lane) {
    const f32x4* s0 = (const f32x4*)(H + (size_t)row * 1024); const f32x4* s1 = s0 + 256;
    f32x4 v0[4], v1[4]; float a0 = 0.f, a1 = 0.f;
#pragma unroll
    for (int i = 0; i < 4; ++i) { v0[i] = s0[i * 64 + lane]; v1[i] = s1[i * 64 + lane]; }
#pragma unroll
    for (int i = 0; i < 4; ++i) { a0 += v0[i][0] * v0[i][0] + v0[i][1] * v0[i][1] + v0[i][2] * v0[i][2] + v0[i][3] * v0[i][3]; a1 += v1[i][0] * v1[i][0] + v1[i][1] * v1[i][1] + v1[i][2] * v1[i][2] + v1[i][3] * v1[i][3]; }
#pragma unroll
    for (int o = 32; o >= 1; o >>= 1) { a0 += __shfl_xor(a0, o); a1 += __shfl_xor(a1, o); }
    const float r0 = rsqrtf(a0 * (1.0f / 1024.0f) + 1e-6f), r1 = rsqrtf(a1 * (1.0f / 1024.0f) + 1e-6f);
#pragma unroll
    for (int i = 0; i < 4; ++i) { *(u32x2*)(HB + (size_t)row * 1024 + (i * 64 + lane) * 4) = pack4(v0[i] * r0); *(u32x2*)(HB + (size_t)(row + 1) * 1024 + (i * 64 + lane) * 4) = pack4(v1[i] * r1); }
}

__device__ __forceinline__ void transpose_tile(const TJob& j, bf16_t* dst, int tile, LAS float* tl) {
    const int tid = threadIdx.x;
    const int ntn = j.N / 256; const int tk = tile / ntn, tn = tile % ntn; const int k0 = tk * 64, n0 = tn * 256;
    {
        const int r = tid >> 6, c4 = (tid & 63) * 4;
        f32x4 v[8];
#pragma unroll
        for (int ps = 0; ps < 8; ++ps) v[ps] = *(const f32x4*)(j.src + (size_t)(k0 + r + 8 * ps) * j.N + n0 + c4);
#pragma unroll
        for (int ps = 0; ps < 8; ++ps) {
            const float g = j.gain ? j.gain[k0 + r + 8 * ps] * j.scale : j.scale;
            LAS float* t = tl + (r + 8 * ps) * 257 + c4;
            t[0] = v[ps][0] * g; t[1] = v[ps][1] * g; t[2] = v[ps][2] * g; t[3] = v[ps][3] * g;
        }
    }
    __syncthreads();
    {
        const int n = tid >> 1, kh = (tid & 1) * 32;
#pragma unroll
        for (int q = 0; q < 4; ++q) {
            const int kc = kh + 8 * q;
            u32x4 w;
            w.x = cvt_pk_bf16(tl[(kc + 0) * 257 + n], tl[(kc + 1) * 257 + n]); w.y = cvt_pk_bf16(tl[(kc + 2) * 257 + n], tl[(kc + 3) * 257 + n]);
            w.z = cvt_pk_bf16(tl[(kc + 4) * 257 + n], tl[(kc + 5) * 257 + n]); w.w = cvt_pk_bf16(tl[(kc + 6) * 257 + n], tl[(kc + 7) * 257 + n]);
            *(u32x4*)(dst + (size_t)(n0 + n) * j.ldo + j.koff + k0 + kc) = w;
        }
    }
    __syncthreads();
}

__device__ __forceinline__ void rowprep2(const float* src, bf16_t* dst, float* rstd, int row, int lane) {
    const f32x4* s0 = (const f32x4*)(src + (size_t)row * 1024); const f32x4* s1 = s0 + 256;
    f32x4 v0[4], v1[4]; float a0 = 0.f, a1 = 0.f;
#pragma unroll
    for (int i = 0; i < 4; ++i) { v0[i] = s0[i * 64 + lane]; v1[i] = s1[i * 64 + lane]; }
#pragma unroll
    for (int i = 0; i < 4; ++i) {
        a0 += v0[i][0] * v0[i][0] + v0[i][1] * v0[i][1] + v0[i][2] * v0[i][2] + v0[i][3] * v0[i][3];
        a1 += v1[i][0] * v1[i][0] + v1[i][1] * v1[i][1] + v1[i][2] * v1[i][2] + v1[i][3] * v1[i][3];
    }
#pragma unroll
    for (int o = 32; o >= 1; o >>= 1) { a0 += __shfl_xor(a0, o); a1 += __shfl_xor(a1, o); }
    const float r0 = rsqrtf(a0 * (1.0f / 1024.0f) + 1e-6f), r1 = rsqrtf(a1 * (1.0f / 1024.0f) + 1e-6f);
#pragma unroll
    for (int i = 0; i < 4; ++i) { *(u32x2*)(dst + (size_t)row * 1024 + (i * 64 + lane) * 4) = pack4(v0[i] * r0); *(u32x2*)(dst + (size_t)(row + 1) * 1024 + (i * 64 + lane) * 4) = pack4(v1[i] * r1); }
}

__device__ __forceinline__ void phase_prep(const Params& p, LAS unsigned char* lds, const int tr_lo, const int tr_hi, const bool rest, const int bid, const int nb) {
    const int tid = threadIdx.x, lane = tid & 63, w = tid >> 6;
    unsigned char* ws = p.ws;
    const int n_tr = tr_hi - tr_lo, n_x = T / 16, n_m = 2048 / 16, n_z = 0, n_cs = T * 8 / 512, n_lb = 2;
    const int total = rest ? n_tr + n_x + n_m + n_z + n_cs + n_lb : n_tr;
    for (int it = bid; it < total; it += nb) {
        int i = it;
        if (i < n_tr) {
            i += tr_lo;
            int jb = 0;
#pragma unroll
            for (int q = 1; q < 9; ++q) if (i >= p.jobs[q].tile0) jb = q;
            transpose_tile(p.jobs[jb], (bf16_t*)(ws + p.jobs[jb].dst_off), i - p.jobs[jb].tile0, (LAS float*)lds);
            continue;
        }
        i -= n_tr;
        if (i < n_x) { rowprep2(p.x, (bf16_t*)(ws + O_XB), (float*)(ws + O_RSTD1), (i * 8 + w) * 2, lane); continue; }
        i -= n_x;
        if (i < n_m) { rowprep2(p.mem, (bf16_t*)(ws + O_MEMB), (float*)(ws + O_RSTDM), (i * 8 + w) * 2, lane); continue; }
        i -= n_m;
        if (i < n_z) { ((float*)(ws + O_SS2))[i * 512 + tid] = 0.f; continue; }
        i -= n_z;
        if (i < n_cs) {
            const int idx = i * 512 + tid, row = idx >> 3, fi = idx & 7;
            const double xr = (double)p.positions[row] * p.inv_freq[fi] * 0.15915494309189535;
            const float fr = (float)(xr - rint(xr));
            float* cs = (float*)(ws + O_CS);
            cs[(size_t)row * 16 + fi] = __builtin_amdgcn_cosf(fr); cs[(size_t)row * 16 + 8 + fi] = __builtin_amdgcn_sinf(fr);
            continue;
        }
        i -= n_cs;
        {
            const int idx = i * 512 + tid, d = idx >> 9, k = idx & 511;
            const float a0 = p.lower_bounds[d * 1024 + k], a1 = p.lower_bounds[d * 1024 + 512 + k];
            ((float*)(ws + O_LBT))[idx] = 1.0f / (1.0f + __expf(a1 - a0));
        }
    }
}

__device__ __forceinline__ s16x4 lds_tr(const LAS bf16_t* ptr) { return __builtin_amdgcn_ds_read_tr16_b64_v4i16((LAS s16x4*)ptr); }
__device__ __forceinline__ bf16x8 cat44(s16x4 a, s16x4 b) { bf16x8 r; r[0] = a[0]; r[1] = a[1]; r[2] = a[2]; r[3] = a[3]; r[4] = b[0]; r[5] = b[1]; r[6] = b[2]; r[7] = b[3]; return r; }

__device__ __forceinline__ void hgrn_item(const Params& p, int item, LAS unsigned char* lds) {
    const int tid = threadIdx.x, lane = tid & 63, w = tid >> 6, l15 = lane & 15, q4 = lane >> 4;
    const int sgi = item & 1, chain = item >> 1, dir = chain & 1, h = (chain >> 1) & 3, b = chain >> 3;
    unsigned char* ws = p.ws;
    bf16_t* QB = (bf16_t*)(ws + O_QB); float* SM = (float*)(ws + O_SMID);
    float btot = 0.f;
    const _Float16* LF = (const _Float16*)(ws + (dir ? O_KKB : O_KKF));
    const bf16_t* QH = (const bf16_t*)(ws + O_QH); const bf16_t* VH = (const bf16_t*)(ws + O_VH);
    bf16_t* O = (bf16_t*)(ws + (dir ? O_OB : O_OF));
    LAS bf16_t* Ps = (LAS bf16_t*)(lds + 106496);
    LAS float* seg = (LAS float*)(lds + 115712);
#define HG_QM(bf_) ((LAS bf16_t*)(lds + (bf_) * 53248))
#define HG_KM(bf_) ((LAS bf16_t*)(lds + (bf_) * 53248 + 17408))
#define HG_VS(bf_) ((LAS bf16_t*)(lds + (bf_) * 53248 + 34816))
#define HG_EMID(bf_) ((LAS float*)(lds + (bf_) * 53248 + 52224))
#define HG_E2(bf_) ((LAS float*)(lds + (bf_) * 53248 + 52224 + 512))
    const int kc = tid & 127, sg = tid >> 7;
    const size_t rb = (size_t)b * SEQ; const int hc = h * 128;
    f32x4 S[8];
#pragma unroll
    for (int i = 0; i < 8; ++i) S[i] = (f32x4){0.f, 0.f, 0.f, 0.f};
    _Float16 lfv[16]; bf16_t qv[16]; u32x4 rv[2];
    f32x4 oacc[4];
#define HG_ROW(g) (rb + (size_t)(dir ? (SEQ - 1 - (g)) : (g)))
    const long rstep = dir ? -512 : 512;
    const int c0 = 32 * sgi, c1 = c0 + 32;
#define HG_PREFETCH(ci) do { \
        { const size_t o_ = HG_ROW((ci) * 64 + sg * 16) * 512 + hc + kc; const _Float16* lp_ = LF + o_; const bf16_t* qp_ = QH + o_; \
          _Pragma("unroll") for (int j = 0; j < 16; ++j) { lfv[j] = lp_[j * rstep]; qv[j] = qp_[j * rstep]; } } \
        _Pragma("unroll") for (int e = 0; e < 2; ++e) { const int c_ = tid + 512 * e; const size_t r_ = HG_ROW((ci) * 64 + (c_ >> 4)); rv[e] = *(const u32x4*)(VH + r_ * 512 + hc + (c_ & 15) * 8); } } while (0)
#define HG_PREP_A() do { float run = 0.f; _Pragma("unroll") for (int j = 0; j < 16; ++j) run += (float)lfv[j]; seg[sg * 128 + kc] = run; } while (0)
#define HG_PREP_B(cidx, bf_) do { \
        LAS bf16_t* Qm_ = HG_QM(bf_); LAS bf16_t* Km_ = HG_KM(bf_); LAS bf16_t* Vs_ = HG_VS(bf_); \
        const float s0 = seg[kc], s1 = seg[128 + kc], s2 = seg[256 + kc], s3 = seg[384 + kc]; \
        const float bmid = s0 + s1, bend = bmid + s2 + s3; \
        const float pre = (sg > 0 ? s0 : 0.f) + (sg > 1 ? s1 : 0.f) + (sg > 2 ? s2 : 0.f) - bmid; \
        const float ek = sgi ? __builtin_amdgcn_exp2f(btot + bmid) : 0.f; \
        bf16_t* qbp = QB + HG_ROW((cidx) * 64 + sg * 16) * 512 + hc + kc; \
        float run_ = pre, eip_ = 0.f; \
        _Pragma("unroll") for (int j = 0; j < 16; ++j) { \
            run_ += (float)lfv[j]; \
            const float d = fminf(fmaxf(run_, -86.f), 86.f);                      \
            const float e = __builtin_amdgcn_exp2f(d), ei = __builtin_amdgcn_rcpf(e); \
            const float fj = (j == 0) ? __builtin_amdgcn_exp2f((float)lfv[0]) : e * eip_;        \
            eip_ = ei; \
            const float qm = bf2f(qv[j]) * e, km = (1.0f - fj) * ei; \
            const int r = sg * 16 + j; \
            Qm_[r * 136 + kc] = (bf16_t)(cvt_pk_bf16(qm, 0.f) & 0xffffu); Km_[r * 136 + kc] = (bf16_t)(cvt_pk_bf16(km, 0.f) & 0xffffu); \
            if (sgi) qbp[j * rstep] = (bf16_t)(cvt_pk_bf16(qm * ek, 0.f) & 0xffffu); \
        } \
        btot += bend; \
        if (sg == 0) { HG_EMID(bf_)[kc] = __builtin_amdgcn_exp2f(bmid); HG_E2(bf_)[kc] = __builtin_amdgcn_exp2f(bend - bmid); } \
        _Pragma("unroll") for (int e = 0; e < 2; ++e) { const int c_ = tid + 512 * e; *(LAS u32x4*)(Vs_ + (c_ >> 4) * 136 + (c_ & 15) * 8) = rv[e]; } \
        if ((cidx) + 1 < c1) HG_PREFETCH((cidx) + 1); \
    } while (0)
#define HG_COMP_C(bf_) do { \
        const LAS bf16_t* Qm_ = HG_QM(bf_); const LAS bf16_t* Km_ = HG_KM(bf_); const LAS float* em_ = HG_EMID(bf_); \
        { const int tt = w >> 1; \
          f32x4 sc0 = (f32x4){0.f, 0.f, 0.f, 0.f}, sc1 = sc0; \
          const LAS bf16_t* qa = Qm_ + (16 * tt + l15) * 136 + 8 * q4; \
          const LAS bf16_t* kb = Km_ + (32 * (w & 1) + l15) * 136 + 8 * q4; \
          _Pragma("unroll") for (int ks = 0; ks < 4; ++ks) { \
              const bf16x8 a = *(const LAS bf16x8*)(qa + 32 * ks); \
              sc0 = __builtin_amdgcn_mfma_f32_16x16x32_bf16(a, *(const LAS bf16x8*)(kb + 32 * ks), sc0, 0, 0, 0); \
              sc1 = __builtin_amdgcn_mfma_f32_16x16x32_bf16(a, *(const LAS bf16x8*)(kb + 16 * 136 + 32 * ks), sc1, 0, 0, 0); } \
          _Pragma("unroll") for (int r = 0; r < 4; ++r) { \
              const int t = 16 * tt + 4 * q4 + r, s_0 = 32 * (w & 1) + l15, s_1 = s_0 + 16; \
              Ps[t * 72 + s_0] = (bf16_t)(cvt_pk_bf16(s_0 <= t ? sc0[r] : 0.f, 0.f) & 0xffffu); \
              Ps[t * 72 + s_1] = (bf16_t)(cvt_pk_bf16(s_1 <= t ? sc1[r] : 0.f, 0.f) & 0xffffu); } } \
        _Pragma("unroll") for (int i = 0; i < 4; ++i) oacc[i] = (f32x4){0.f, 0.f, 0.f, 0.f}; \
        _Pragma("unroll") for (int i = 0; i < 4; ++i) { \
            S[2 * i] = S[2 * i] * *(const LAS f32x4*)(em_ + 32 * i + 4 * q4); S[2 * i + 1] = S[2 * i + 1] * *(const LAS f32x4*)(em_ + 32 * i + 16 + 4 * q4); \
            u32x4 bw; bw.x = cvt_pk_bf16(S[2 * i][0], S[2 * i][1]); bw.y = cvt_pk_bf16(S[2 * i][2], S[2 * i][3]); bw.z = cvt_pk_bf16(S[2 * i + 1][0], S[2 * i + 1][1]); bw.w = cvt_pk_bf16(S[2 * i + 1][2], S[2 * i + 1][3]); \
            const bf16x8 sb = __builtin_bit_cast(bf16x8, bw); \
            _Pragma("unroll") for (int tt = 0; tt < 4; ++tt) { \
                const LAS bf16_t* qa = Qm_ + (16 * tt + l15) * 136 + 32 * i + 4 * q4; \
                const u32x2 lo = *(const LAS u32x2*)qa, hi = *(const LAS u32x2*)(qa + 16); \
                u32x4 aw; aw.x = lo.x; aw.y = lo.y; aw.z = hi.x; aw.w = hi.y; \
                oacc[tt] = __builtin_amdgcn_mfma_f32_16x16x32_bf16(__builtin_bit_cast(bf16x8, aw), sb, oacc[tt], 0, 0, 0); } } \
    } while (0)
#define HG_COMP_D(cidx, bf_) do { \
        const LAS bf16_t* Km_ = HG_KM(bf_); const LAS bf16_t* Vs_ = HG_VS(bf_); const LAS float* e2_ = HG_E2(bf_); \
        bf16x8 vb[2]; \
        _Pragma("unroll") for (int i = 0; i < 2; ++i) { \
            const LAS bf16_t* va = Vs_ + (32 * i + 8 * q4 + (l15 >> 2)) * 136 + 16 * w + 4 * (l15 & 3); \
            vb[i] = cat44(lds_tr(va), lds_tr(va + 4 * 136)); } \
        _Pragma("unroll") for (int tt = 0; tt < 4; ++tt) \
            _Pragma("unroll") for (int i = 0; i < 2; ++i) { \
                if (32 * i > 16 * tt + 15) continue; \
                const bf16x8 pa = *(const LAS bf16x8*)(Ps + (16 * tt + l15) * 72 + 32 * i + 8 * q4); \
                oacc[tt] = __builtin_amdgcn_mfma_f32_16x16x32_bf16(pa, vb[i], oacc[tt], 0, 0, 0); } \
        bf16_t* op = O + HG_ROW((cidx) * 64 + 4 * q4) * 512 + hc + 16 * w + l15; \
        _Pragma("unroll") for (int tt = 0; tt < 4; ++tt) \
            _Pragma("unroll") for (int r = 0; r < 4; ++r) op[(16 * tt + r) * rstep] = (bf16_t)(cvt_pk_bf16(oacc[tt][r], 0.f) & 0xffffu); \
        _Pragma("unroll") for (int kt = 0; kt < 8; ++kt) { \
            _Pragma("unroll") for (int i = 0; i < 2; ++i) { \
                const LAS bf16_t* ka = Km_ + (32 * i + 8 * q4 + (l15 >> 2)) * 136 + 16 * kt + 4 * (l15 & 3); \
                S[kt] = __builtin_amdgcn_mfma_f32_16x16x32_bf16(cat44(lds_tr(ka), lds_tr(ka + 4 * 136)), vb[i], S[kt], 0, 0, 0); } \
            S[kt] = S[kt] * *(const LAS f32x4*)(e2_ + 16 * kt + 4 * q4); } \
    } while (0)
    HG_PREFETCH(c0);
    HG_PREP_A();
    __syncthreads();
    HG_PREP_B(c0, 0);
    __syncthreads();
    HG_PREP_A();
    __syncthreads();
    for (int ci = c0; ci < c1; ++ci) {
        const int bf = (ci - c0) & 1;
        const bool more = ci + 1 < c1, more2 = ci + 2 < c1;
        if (bf == 0) { if (more) HG_PREP_B(ci + 1, 1); HG_COMP_C(0); } else { if (more) HG_PREP_B(ci + 1, 0); HG_COMP_C(1); }
        __syncthreads();
        if (bf == 0) HG_COMP_D(ci, 0); else HG_COMP_D(ci, 1);
        if (more2) HG_PREP_A();
        __syncthreads();
    }
#undef HG_PREP_A
#undef HG_PREP_B
#undef HG_COMP_C
#undef HG_COMP_D
#undef HG_QM
#undef HG_KM
#undef HG_VS
#undef HG_EMID
#undef HG_E2
    if (sgi == 0) {
#pragma unroll
        for (int kt = 0; kt < 8; ++kt) *(f32x4*)(SM + ((size_t)chain * 128 + 16 * w + l15) * 128 + 16 * kt + 4 * q4) = S[kt];
    }
#undef HG_PREFETCH
}

__device__ __forceinline__ void hgrn_carry_item(const Params& p, int item, LAS unsigned char* lds, int& staged_chain) {
    const int tid = threadIdx.x, lane = tid & 63, w = tid >> 6, l15 = lane & 15, q4 = lane >> 4;
    const int tile = item & 15, chain = item >> 4, dir = chain & 1, h = (chain >> 1) & 3, b = chain >> 3;
    unsigned char* ws = p.ws;
    const bf16_t* QB = (const bf16_t*)(ws + O_QB); const float* SM = (const float*)(ws + O_SMID);
    bf16_t* O = (bf16_t*)(ws + (dir ? O_OB : O_OF));
    LAS bf16_t* Sm = (LAS bf16_t*)lds;
    if (staged_chain != chain) {
        __syncthreads();
        const int v = tid >> 2, kq = (tid & 3) * 32;
        const float* sp = SM + ((size_t)chain * 128 + v) * 128 + kq;
        f32x4 t[8];
#pragma unroll
        for (int e = 0; e < 8; ++e) t[e] = *(const f32x4*)(sp + 4 * e);
#pragma unroll
        for (int e = 0; e < 4; ++e) { const u32x2 lo = pack4(t[2 * e]), hi = pack4(t[2 * e + 1]); *(LAS u32x4*)(Sm + v * 136 + kq + 8 * e) = (u32x4){lo.x, lo.y, hi.x, hi.y}; }
        __syncthreads();
        staged_chain = chain;
    }
    const size_t rb = (size_t)b * SEQ; const int hc = h * 128;
    const int g0 = SEQ / 2 + tile * 128 + w * 16;
    bf16x8 qa[4];
#pragma unroll
    for (int ks = 0; ks < 4; ++ks) qa[ks] = *(const bf16x8*)(QB + HG_ROW(g0 + l15) * 512 + hc + 32 * ks + 8 * q4);
#pragma unroll
    for (int vt = 0; vt < 8; ++vt) {
        f32x4 acc = (f32x4){0.f, 0.f, 0.f, 0.f};
        const LAS bf16_t* sp = Sm + (16 * vt + l15) * 136 + 8 * q4;
#pragma unroll
        for (int ks = 0; ks < 4; ++ks) acc = __builtin_amdgcn_mfma_f32_16x16x32_bf16(qa[ks], *(const LAS bf16x8*)(sp + 32 * ks), acc, 0, 0, 0);
#pragma unroll
        for (int r = 0; r < 4; ++r) {
            bf16_t* op = O + HG_ROW(g0 + 4 * q4 + r) * 512 + hc + 16 * vt + l15;
            *op = (bf16_t)(cvt_pk_bf16(bf2f(*op) + acc[r], 0.f) & 0xffffu);
        }
    }
}
#undef HG_ROW

__device__ __forceinline__ void wattn_item(const Params& p, int item, LAS unsigned char* lds) {
    const int tid = threadIdx.x, lane = tid & 63, w = tid >> 6, l15 = lane & 15, q4 = lane >> 4;
    const int qh = item & 7, nb = (item >> 3) & 31, b = item >> 8, hk = qh >> 2;
    unsigned char* ws = p.ws;
    const bf16_t* QA = (const bf16_t*)(ws + O_QA); const bf16_t* KA = (const bf16_t*)(ws + O_KA); const bf16_t* VA = (const bf16_t*)(ws + O_VA);
    bf16_t* OA = (bf16_t*)(ws + O_OA);
    LAS bf16_t* Ks = (LAS bf16_t*)lds; LAS bf16_t* Vs = Ks + 400 * 72;
    {
        u32x4 sk[7], sv[7];
#pragma unroll
        for (int e = 0; e < 7; ++e) {
            const int r = (tid >> 3) + 64 * e, ch = (tid & 7) * 8; const int tok = (nb - 1) * 128 + r;
            sk[e] = (u32x4){0u, 0u, 0u, 0u}; sv[e] = sk[e];
            if (r < 384 && tok >= 0 && tok < SEQ) { const size_t row = (size_t)b * SEQ + tok; sk[e] = *(const u32x4*)(KA + row * 128 + hk * 64 + ch); sv[e] = *(const u32x4*)(VA + row * 128 + hk * 64 + ch); }
        }
#pragma unroll
        for (int e = 0; e < 7; ++e) {
            const int r = (tid >> 3) + 64 * e, ch = (tid & 7) * 8;
            if (r < 400) { *(LAS u32x4*)(Ks + r * 72 + ch) = sk[e]; *(LAS u32x4*)(Vs + r * 72 + ch) = sv[e]; }
        }
    }
    __syncthreads();
    const size_t qrow = (size_t)b * SEQ + nb * 128 + w * 16 + l15;
    const bf16x8 bq0 = *(const bf16x8*)(QA + qrow * 512 + qh * 64 + 8 * q4), bq1 = *(const bf16x8*)(QA + qrow * 512 + qh * 64 + 32 + 8 * q4);
    f32x4 sc[18];
#pragma unroll
    for (int s = 0; s < 18; ++s) {
        const LAS bf16_t* kr = Ks + (16 * (w + s) + l15) * 72 + 8 * q4;
        const bf16x8 a0 = *(const LAS bf16x8*)kr, a1 = *(const LAS bf16x8*)(kr + 32);
        f32x4 z = (f32x4){0.f, 0.f, 0.f, 0.f};
        z = __builtin_amdgcn_mfma_f32_16x16x32_bf16(a0, bq0, z, 0, 0, 0);
        sc[s] = __builtin_amdgcn_mfma_f32_16x16x32_bf16(a1, bq1, z, 0, 0, 0);
        if ((s & 3) == 3) __builtin_amdgcn_sched_barrier(0);
    }
    const int tq = 16 * w + l15;
    const int lo = max(tq, (1 - nb) * 128), hi = min(tq + 256, SEQ - 1 - (nb - 1) * 128);
    const int sl0 = 16 * w + 4 * q4;
    float mx = -1e30f;
#pragma unroll
    for (int s = 0; s < 18; ++s)
#pragma unroll
        for (int r = 0; r < 4; ++r) {
            const int sl = sl0 + 16 * s + r;
            const int neg = ((sl - lo) | (hi - sl)) >> 31;
            const float v = sc[s][r] + __uint_as_float((unsigned)neg & 0xF149F2CAu);
            sc[s][r] = v; mx = fmaxf(mx, v);
        }
    mx = fmaxf(mx, __shfl_xor(mx, 16)); mx = fmaxf(mx, __shfl_xor(mx, 32));
    const float sk = p.sink[qh]; mx = fmaxf(mx, sk);
    float sum = 0.f;
#pragma unroll
    for (int s = 0; s < 18; ++s)
#pragma unroll
        for (int r = 0; r < 4; ++r) { const float e = __expf(sc[s][r] - mx); sc[s][r] = e; sum += e; }
    sum += __shfl_xor(sum, 16); sum += __shfl_xor(sum, 32);
    sum += __expf(sk - mx);
    const float inv = 1.0f / sum;
    f32x4 oc[4];
#pragma unroll
    for (int d = 0; d < 4; ++d) oc[d] = (f32x4){0.f, 0.f, 0.f, 0.f};
#pragma unroll
    for (int i = 0; i < 9; ++i) {
        u32x4 pw; pw.x = cvt_pk_bf16(sc[2 * i][0] * inv, sc[2 * i][1] * inv); pw.y = cvt_pk_bf16(sc[2 * i][2] * inv, sc[2 * i][3] * inv);
        pw.z = cvt_pk_bf16(sc[2 * i + 1][0] * inv, sc[2 * i + 1][1] * inv); pw.w = cvt_pk_bf16(sc[2 * i + 1][2] * inv, sc[2 * i + 1][3] * inv);
        const bf16x8 pa = __builtin_bit_cast(bf16x8, pw);
        const LAS bf16_t* vb = Vs + (16 * (w + 2 * i) + 4 * q4 + (l15 >> 2)) * 72 + 4 * (l15 & 3);
#pragma unroll
        for (int d = 0; d < 4; ++d) {
            const s16x4 v0 = lds_tr(vb + 16 * d), v1 = lds_tr(vb + 16 * 72 + 16 * d);
            bf16x8 bv; bv[0] = v0[0]; bv[1] = v0[1]; bv[2] = v0[2]; bv[3] = v0[3]; bv[4] = v1[0]; bv[5] = v1[1]; bv[6] = v1[2]; bv[7] = v1[3];
            oc[d] = __builtin_amdgcn_mfma_f32_16x16x32_bf16(pa, bv, oc[d], 0, 0, 0);
        }
        __builtin_amdgcn_sched_barrier(0);
    }
    const size_t orow = (size_t)b * SEQ + nb * 128 + w * 16 + 4 * q4;
#pragma unroll
    for (int d = 0; d < 4; ++d)
#pragma unroll
        for (int r = 0; r < 4; ++r) OA[(orow + r) * 1024 + 512 + qh * 64 + 16 * d + l15] = (bf16_t)(cvt_pk_bf16(oc[d][r], 0.f) & 0xffffu);
    __syncthreads();
}

__device__ __forceinline__ void hgrn_combine_row(const Params& p, int row, int lane) {
    unsigned char* ws = p.ws;
    const u32x4 a = *(const u32x4*)((const bf16_t*)(ws + O_OF) + (size_t)row * 512 + lane * 8), c = *(const u32x4*)((const bf16_t*)(ws + O_OB) + (size_t)row * 512 + lane * 8);
    const u32x4 g = *(const u32x4*)((const bf16_t*)(ws + O_SG) + (size_t)row * 512 + lane * 8);
    float o[8];
    o[0] = bflo(a.x) + bflo(c.x); o[1] = bfhi(a.x) + bfhi(c.x); o[2] = bflo(a.y) + bflo(c.y); o[3] = bfhi(a.y) + bfhi(c.y);
    o[4] = bflo(a.z) + bflo(c.z); o[5] = bfhi(a.z) + bfhi(c.z); o[6] = bflo(a.w) + bflo(c.w); o[7] = bfhi(a.w) + bfhi(c.w);
    float ss = 0.f;
#pragma unroll
    for (int i = 0; i < 8; ++i) ss += o[i] * o[i];
    ss += __shfl_xor(ss, 1); ss += __shfl_xor(ss, 2); ss += __shfl_xor(ss, 4); ss += __shfl_xor(ss, 8);
    const float rs = rsqrtf(ss * (1.0f / 128.0f) + 1e-6f);
    const f32x4 n0 = *(const f32x4*)(p.hg_norm + lane * 8), n1 = *(const f32x4*)(p.hg_norm + lane * 8 + 4);
    u32x4 w;
    w.x = cvt_pk_bf16(o[0] * rs * n0[0] * bflo(g.x), o[1] * rs * n0[1] * bfhi(g.x)); w.y = cvt_pk_bf16(o[2] * rs * n0[2] * bflo(g.y), o[3] * rs * n0[3] * bfhi(g.y));
    w.z = cvt_pk_bf16(o[4] * rs * n1[0] * bflo(g.z), o[5] * rs * n1[1] * bfhi(g.z)); w.w = cvt_pk_bf16(o[6] * rs * n1[2] * bflo(g.w), o[7] * rs * n1[3] * bfhi(g.w));
    *(u32x4*)((bf16_t*)(ws + O_OA) + (size_t)row * 1024 + lane * 8) = w;
}

__device__ __forceinline__ void mattn_item(const Params& p, int item, LAS unsigned char* lds) {
    const int tid = threadIdx.x, lane = tid & 63, w = tid >> 6, l15 = lane & 15, q4 = lane >> 4;
    const int qt = item & 31, hd = (item >> 5) & 3, b = item >> 7;
    unsigned char* ws = p.ws;
    const bf16_t* QM = (const bf16_t*)(ws + O_QM); const bf16_t* KVM = (const bf16_t*)(ws + O_KVM); bf16_t* OM = (bf16_t*)(ws + O_OM);
    LAS bf16_t* Ks = (LAS bf16_t*)lds;
#pragma unroll
    for (int hf = 0; hf < 2; ++hf) {
        u32x4 st[8];
#pragma unroll
        for (int e = 0; e < 8; ++e) st[e] = *(const u32x4*)(KVM + (size_t)(b * 256 + (tid >> 5) + 16 * (8 * hf + e)) * 2048 +  hd * 256 + (tid & 31) * 8);
#pragma unroll
        for (int e = 0; e < 8; ++e) *(LAS u32x4*)(Ks + ((tid >> 5) + 16 * (8 * hf + e)) * 264 + (tid & 31) * 8) = st[e];
    }
    __syncthreads();
    const size_t qrow = (size_t)b * SEQ + qt * 128 + w * 16 + l15;
    float rsq;
    { const f32x4* q_ = (const f32x4*)((const float*)(ws + O_SSP2) + qrow * 16); const f32x4 t_ = (q_[0] + q_[1]) + (q_[2] + q_[3]); rsq = rsqrtf(((t_[0] + t_[1]) + (t_[2] + t_[3])) * (1.0f / 1024.0f) + 1e-6f); }
    bf16x8 bq[8];
#pragma unroll
    for (int d = 0; d < 8; ++d) bq[d] = *(const bf16x8*)(QM + qrow * 1024 + hd * 256 + d * 32 + 8 * q4);
    f32x4 sc[16];
#pragma unroll
    for (int s = 0; s < 16; ++s) {
        const LAS bf16_t* kr = Ks + (16 * s + l15) * 264 + 8 * q4;
        f32x4 z = (f32x4){0.f, 0.f, 0.f, 0.f};
#pragma unroll
        for (int d = 0; d < 8; ++d) z = __builtin_amdgcn_mfma_f32_16x16x32_bf16(*(const LAS bf16x8*)(kr + 32 * d), bq[d], z, 0, 0, 0);
        sc[s] = z;
        if (s & 1) __builtin_amdgcn_sched_barrier(0);
    }
    float mx = -1e30f;
#pragma unroll
    for (int s = 0; s < 16; ++s)
#pragma unroll
        for (int r = 0; r < 4; ++r) mx = fmaxf(mx, sc[s][r]);
    mx = fmaxf(mx, __shfl_xor(mx, 16)); mx = fmaxf(mx, __shfl_xor(mx, 32));
    float sum = 0.f;
#pragma unroll
    for (int s = 0; s < 16; ++s)
#pragma unroll
        for (int r = 0; r < 4; ++r) { const float e = __expf((sc[s][r] - mx) * rsq); sc[s][r] = e; sum += e; }
    sum += __shfl_xor(sum, 16); sum += __shfl_xor(sum, 32);
    const float inv = 1.0f / sum;
    bf16x8 pa[8];
#pragma unroll
    for (int i = 0; i < 8; ++i) {
        u32x4 pw; pw.x = cvt_pk_bf16(sc[2 * i][0] * inv, sc[2 * i][1] * inv); pw.y = cvt_pk_bf16(sc[2 * i][2] * inv, sc[2 * i][3] * inv);
        pw.z = cvt_pk_bf16(sc[2 * i + 1][0] * inv, sc[2 * i + 1][1] * inv); pw.w = cvt_pk_bf16(sc[2 * i + 1][2] * inv, sc[2 * i + 1][3] * inv);
        pa[i] = __builtin_bit_cast(bf16x8, pw);
    }
    __syncthreads();
#pragma unroll
    for (int hf = 0; hf < 2; ++hf) {
        u32x4 st[8];
#pragma unroll
        for (int e = 0; e < 8; ++e) st[e] = *(const u32x4*)(KVM + (size_t)(b * 256 + (tid >> 5) + 16 * (8 * hf + e)) * 2048 + 1024 + hd * 256 + (tid & 31) * 8);
#pragma unroll
        for (int e = 0; e < 8; ++e) *(LAS u32x4*)(Ks + ((tid >> 5) + 16 * (8 * hf + e)) * 264 + (tid & 31) * 8) = st[e];
    }
    __syncthreads();
    const size_t orow = (size_t)b * SEQ + qt * 128 + w * 16 + 4 * q4;
#pragma unroll
    for (int dh = 0; dh < 2; ++dh) {
        f32x4 oc[8];
#pragma unroll
        for (int d = 0; d < 8; ++d) oc[d] = (f32x4){0.f, 0.f, 0.f, 0.f};
#pragma unroll
        for (int i = 0; i < 8; ++i) {
            const LAS bf16_t* vb = Ks + (32 * i + 4 * q4 + (l15 >> 2)) * 264 + dh * 128 + 4 * (l15 & 3);
#pragma unroll
            for (int d = 0; d < 8; ++d) {
                const s16x4 v0 = lds_tr(vb + 16 * d), v1 = lds_tr(vb + 16 * 264 + 16 * d);
                bf16x8 bv; bv[0] = v0[0]; bv[1] = v0[1]; bv[2] = v0[2]; bv[3] = v0[3]; bv[4] = v1[0]; bv[5] = v1[1]; bv[6] = v1[2]; bv[7] = v1[3];
                oc[d] = __builtin_amdgcn_mfma_f32_16x16x32_bf16(pa[i], bv, oc[d], 0, 0, 0);
            }
            __builtin_amdgcn_sched_barrier(0);
        }
#pragma unroll
        for (int d = 0; d < 8; ++d)
#pragma unroll
            for (int r = 0; r < 4; ++r) OM[(orow + r) * 1024 + hd * 256 + dh * 128 + 16 * d + l15] = (bf16_t)(cvt_pk_bf16(oc[d][r], 0.f) & 0xffffu);
    }
    __syncthreads();
}

#ifndef DBG
#define DBG 0
#endif
#ifndef STOP_AFTER
#define STOP_AFTER 99
#endif
#define XB_TMO      128
#define XB_XCNT(j)  (256  + 64 * (j))
#define XB_XSUB(j)  (1280 + 64 * (j))
#define XB_XGEN(j)  (2304 + 64 * (j))
#define XB_TOP      3328
#define XB_TOPGEN   3392
#define XCD_BAR_WORDS 3456
#define XB_SPIN_CAP (1u << 18)

__device__ __forceinline__ unsigned xb_ld(unsigned* p)              { return __hip_atomic_load(p, __ATOMIC_RELAXED, __HIP_MEMORY_SCOPE_AGENT); }
__device__ __forceinline__ unsigned xb_add(unsigned* p, unsigned v) { return __hip_atomic_fetch_add(p, v, __ATOMIC_RELAXED, __HIP_MEMORY_SCOPE_AGENT); }
__device__ __forceinline__ unsigned xb_xcc_id() { return (unsigned)__builtin_amdgcn_s_getreg((3 << 11) | 20) & 0xFu; }
#define XB_SPIN(cond, bar) do { unsigned _sp = 0; while (cond) { __builtin_amdgcn_s_sleep(1); \
    if ((++_sp & 255u) == 0u) { if (xb_ld(&(bar)[XB_TMO])) break; if (_sp > XB_SPIN_CAP) { atomicAdd(&(bar)[XB_TMO], 1u); break; } } } } while (0)

struct XcdBarrier {
    unsigned* bar; unsigned x;
    volatile LAS unsigned* st;
};

__device__ __forceinline__ XcdBarrier xcd_barrier_post(unsigned* bar, volatile LAS unsigned* st) {
    XcdBarrier b; b.bar = bar; b.x = xb_xcc_id(); b.st = st;
    if (threadIdx.x == 0) (void)xb_add(&bar[XB_XCNT(b.x)], 1u);
    return b;
}
__device__ __forceinline__ void xcd_barrier_complete(unsigned* bar, unsigned x, unsigned& nloc, unsigned& nx) {
    const unsigned G = gridDim.x * gridDim.y * gridDim.z;
    unsigned sum, cnt, mine, sp = 0u;
    for (;;) {
        sum = 0u; cnt = 0u; mine = 0u;
#pragma unroll
        for (unsigned j = 0; j < 16; ++j) { const unsigned c = xb_ld(&bar[XB_XCNT(j)]); sum += c; cnt += (c > 0u) ? 1u : 0u; mine = (j == x) ? c : mine; }
        if (sum == G) break;
        __builtin_amdgcn_s_sleep(1);
        if ((++sp & 255u) == 0u) { if (xb_ld(&bar[XB_TMO])) break; if (sp > XB_SPIN_CAP) { atomicAdd(&bar[XB_TMO], 1u); break; } }
    }
    nloc = mine > 0u ? mine : 1u; nx = cnt > 0u ? cnt : 1u;
}

__device__ __forceinline__ void xcd_barrier(const XcdBarrier& b) {
    asm volatile("s_waitcnt vmcnt(0)" ::: "memory");
    __syncthreads();
    if (threadIdx.x == 0) {
        unsigned* bar = b.bar;
        __builtin_amdgcn_s_waitcnt(0);
        unsigned nloc = b.st[0], nx = b.st[1];
        if (nloc == 0u) { xcd_barrier_complete(bar, b.x, nloc, nx); b.st[0] = nloc; b.st[1] = nx; }
        const unsigned old = xb_add(&bar[XB_XSUB(b.x)], 1u);
        const unsigned gen = old / nloc;
        if (old + 1u == (gen + 1u) * nloc) {
            __builtin_amdgcn_fence(__ATOMIC_RELEASE, "agent");
            asm volatile("s_waitcnt vmcnt(0)" ::: "memory");
            const unsigned og = xb_add(&bar[XB_TOP], 1u);
            const unsigned tg = og / nx;
            if (og + 1u == (tg + 1u) * nx) xb_add(&bar[XB_TOPGEN], 1u);
            else XB_SPIN(xb_ld(&bar[XB_TOPGEN]) == tg, bar);
            __builtin_amdgcn_fence(__ATOMIC_ACQUIRE, "agent");
            xb_add(&bar[XB_XGEN(b.x)], 1u);
            asm volatile("s_waitcnt vmcnt(0)" ::: "memory");
        } else {
            XB_SPIN(xb_ld(&bar[XB_XGEN(b.x)]) == gen, bar);
            __builtin_amdgcn_fence(__ATOMIC_ACQUIRE, "agent");
            asm volatile("s_waitcnt vmcnt(0)" ::: "memory");
        }
    }
    __syncthreads();
}

#define GRID_SYNC() xcd_barrier(xb)
__global__ void __launch_bounds__(512) mk_kernel(Params p) {
    cg::grid_group grid = cg::this_grid();
    extern __shared__ __attribute__((aligned(16))) unsigned char lds_raw[];
    LAS unsigned char* lds = (LAS unsigned char*)lds_raw;
    unsigned char* ws = p.ws;
    const int tid = threadIdx.x, lane = tid & 63, w = tid >> 6;
    const int G = gridDim.x, c = blockIdx.x;

    volatile LAS unsigned* xst = (volatile LAS unsigned*)(lds + 143344);
    if (tid == 0) { xst[0] = 0u; xst[1] = 0u; }
    __syncthreads();
    const XcdBarrier xb = xcd_barrier_post((unsigned*)(ws + O_BAR), xst);
    if (p.njobs < 0) grid.sync();
    phase_prep(p, lds, 0, p.jobs[2].tile0, true, c, G);
    GRID_SYNC();

    {
        pg8::StaticOrder S; S.init(T, 5376, G, c);
        EpiProj E; E.rstd = (const float*)(ws + O_RSTD1); E.lbt = (const float*)(ws + O_LBT); E.cs = (const float*)(ws + O_CS);
        E.QH = (bf16_t*)(ws + O_QH); E.VH = (bf16_t*)(ws + O_VH); E.SG = (bf16_t*)(ws + O_SG); E.QA = (bf16_t*)(ws + O_QA); E.KA = (bf16_t*)(ws + O_KA); E.VA = (bf16_t*)(ws + O_VA);
        E.GR = (bf16_t*)p.out; E.GA = (bf16_t*)p.out + (size_t)T * 1024; E.KKF = (_Float16*)(ws + O_KKF); E.KKB = (_Float16*)(ws + O_KKB);
        pg8::gemm_phase(lds, pg8::Gemm{(const bf16_t*)(ws + O_XB), (const bf16_t*)(ws + O_WIN), T, 5376, 1024, 1024, 1024}, S, E);
        pg8::StaticOrder S2; S2.init(2048, 2048, G, G - 1 - c);
        EpiScale<2> E2; E2.rs = nullptr; E2.O = (bf16_t*)(ws + O_KVM); E2.ldo = 2048; E2.O2 = E2.O; E2.split = 1 << 30;
        pg8::gemm_phase(lds, pg8::Gemm{(const bf16_t*)(ws + O_MEMB), (const bf16_t*)(ws + O_WMKV), 2048, 2048, 1024, 1024, 1024}, S2, E2);
    }
    GRID_SYNC();

    if (DBG == 1) {
        const unsigned short* a0 = (const unsigned short*)(ws + O_QH); const unsigned short* a1 = (const unsigned short*)(ws + O_KKF); const unsigned short* a2 = (const unsigned short*)(ws + O_KKB);
        const unsigned short* a3 = (const unsigned short*)(ws + O_VH); const unsigned short* a4 = (const unsigned short*)(ws + O_SG); const unsigned short* a5 = (const unsigned short*)(ws + O_QA);
        const unsigned short* a6 = (const unsigned short*)(ws + O_KA); const unsigned short* a7 = (const unsigned short*)(ws + O_VA);
        for (size_t idx = (size_t)blockIdx.x * 512 + threadIdx.x; idx < (size_t)T * 1024; idx += (size_t)gridDim.x * 512) {
            const size_t row = idx >> 10; const int c = (int)(idx & 1023), c5 = c & 511, c1 = c & 127; float v;
            if (c < 512) v = bf2f(a0[row * 512 + c5]) + bf2f(a1[row * 512 + c5]) * 0.001f + bf2f(a2[row * 512 + c5]) * 0.001f + bf2f(a3[row * 512 + c5]);
            else v = bf2f(a4[row * 512 + c5]) + bf2f(a5[row * 512 + c5]) + bf2f(a6[row * 128 + c1]) + bf2f(a7[row * 128 + c1]);
            p.out[idx] = v;
        }
        return;
    }
    {
        const int nh = G >= 256 ? 128 : 0;
        if (c < nh || nh == 0) for (int it = c; it < 128; it += (nh ? nh : G)) hgrn_item(p, it, lds);
        if (c >= nh) phase_prep(p, lds, p.jobs[2].tile0, p.ntiles, false, c - nh, G - nh);
        {
            unsigned* qctr = (unsigned*)(ws + O_BAR);
            volatile LAS unsigned* qslot = (volatile LAS unsigned*)(lds + 143352);
            for (;;) {
                __syncthreads();
                if (tid == 0) *qslot = __hip_atomic_fetch_add(qctr, 1u, __ATOMIC_RELAXED, __HIP_MEMORY_SCOPE_AGENT);
                __syncthreads();
                const unsigned it = *qslot;
                if (it >= 2048u) break;
                wattn_item(p, (int)it, lds);
            }
        }
    }
    GRID_SYNC();
    {
        const int per = (1024 + G - 1) / G; int staged = -1;
        for (int it = c * per; it < (c + 1) * per && it < 1024; ++it) hgrn_carry_item(p, it, lds, staged);
        __syncthreads();
    }
    GRID_SYNC();
    for (int r = c * 8 + w; r < T; r += G * 8) hgrn_combine_row(p, r, lane);
    GRID_SYNC();

    if (DBG == 2) {
        const unsigned short* a0 = (const unsigned short*)(ws + O_OA);
        for (size_t idx = (size_t)blockIdx.x * 512 + threadIdx.x; idx < (size_t)T * 1024; idx += (size_t)gridDim.x * 512) p.out[idx] = bf2f(a0[idx]);
        return;
    }
    {
        pg8::StaticOrder S; S.init(T, 1024, G, c);
        EpiMergeFused E; E.GR = (const bf16_t*)p.out; E.GA = (const bf16_t*)p.out + (size_t)T * 1024; E.O = (bf16_t*)(ws + O_MERGED);
        pg8::gemm_phase(lds, pg8::Gemm{(const bf16_t*)(ws + O_OA), (const bf16_t*)(ws + O_WMID), T, 1024, 1024, 1024, 1024}, S, E);
    }
    GRID_SYNC();
    if (DBG == 3) {
        const unsigned short* a0 = (const unsigned short*)(ws + O_MERGED);
        for (size_t idx = (size_t)blockIdx.x * 512 + threadIdx.x; idx < (size_t)T * 1024; idx += (size_t)gridDim.x * 512) p.out[idx] = bf2f(a0[idx]);
        return;
    }
    {
        pg8::StaticOrder S; S.init(T, 1024, G, c);
        EpiRes<0> E; E.base = p.x; E.HB = (bf16_t*)(ws + O_HB1); E.ssp = (float*)(ws + O_SSP2);
        pg8::gemm_phase(lds, pg8::Gemm{(const bf16_t*)(ws + O_MERGED), (const bf16_t*)(ws + O_WOUT), T, 1024, 1024, 1024, 1024}, S, E);
    }
    GRID_SYNC();
    if (STOP_AFTER == 4) return;
    {
        pg8::StaticOrder S; S.init(T, 1024, G, c);
        EpiScale<2> E; E.rs = nullptr; E.O = (bf16_t*)(ws + O_QM); E.ldo = 1024; E.O2 = E.O; E.split = 1 << 30;
        pg8::gemm_phase(lds, pg8::Gemm{(const bf16_t*)(ws + O_HB1), (const bf16_t*)(ws + O_WMQ), T, 1024, 1024, 1024, 1024}, S, E);
        asm volatile("s_waitcnt vmcnt(0)" ::: "memory");
        __syncthreads();
        __builtin_amdgcn_fence(__ATOMIC_ACQUIRE, "agent");
        pg8::Unit u;
        for (int i = 0; S.next(i, u); ++i)
#pragma nounroll
            for (int hq = 0; hq < 2; ++hq) mattn_item(p, ((u.pm >> 4) << 7) | (u.pn << 5) | (2 * (u.pm & 15) + hq), lds);
    }
    GRID_SYNC();
    {
        pg8::StaticOrder S; S.init(T, 1024, G, c);
        EpiRes<1> E; E.base = ws + O_HB1; E.HB = (bf16_t*)(ws + O_HB2); E.ssp = (float*)(ws + O_SSP3);
        pg8::gemm_phase(lds, pg8::Gemm{(const bf16_t*)(ws + O_OM), (const bf16_t*)(ws + O_WMO), T, 1024, 1024, 1024, 1024}, S, E);
    }
    GRID_SYNC();
    if (STOP_AFTER == 7) return;
    {
        pg8::StaticOrder S; S.init(T, 5632, G, c);
        EpiScale<2> E; E.rs = nullptr; E.O = (bf16_t*)(ws + O_U); E.ldo = 2816; E.O2 = (bf16_t*)(ws + O_G); E.split = 2816;
        pg8::gemm_phase(lds, pg8::Gemm{(const bf16_t*)(ws + O_HB2), (const bf16_t*)(ws + O_WUP), T, 5632, 1024, 1024, 1024}, S, E);
    }
    GRID_SYNC();
    {
        bf16_t* U = (bf16_t*)(ws + O_U); const bf16_t* Gt = (const bf16_t*)(ws + O_G);
        {
            const int ch = (tid < 352 ? tid : 0) * 8;
            f32x4 w0[2], w1[2], w2[2], cb[2];
#pragma unroll
            for (int hh = 0; hh < 2; ++hh) { w0[hh] = *(const f32x4*)(p.conv_w + ch + 4 * hh); w1[hh] = *(const f32x4*)(p.conv_w + 2816 + ch + 4 * hh); w2[hh] = *(const f32x4*)(p.conv_w + 5632 + ch + 4 * hh); cb[hh] = *(const f32x4*)(p.conv_b + ch + 4 * hh); }
            const u32x4 z4 = (u32x4){0u, 0u, 0u, 0u};
            const float* ssp3 = (const float*)(ws + O_SSP3);
#define ROW_RS(r_) ({ const f32x4* q_ = (const f32x4*)(ssp3 + (size_t)(r_) * 16); const f32x4 t_ = (q_[0] + q_[1]) + (q_[2] + q_[3]); rsqrtf(((t_[0] + t_[1]) + (t_[2] + t_[3])) * (1.0f / 1024.0f) + 1e-6f); })
            LAS float* rsl = (LAS float*)lds;
            for (int sgm = c; sgm < T / 128; sgm += G) {
                const int r0 = sgm * 128;
                __syncthreads();
                if (tid < 130) { const int rw = r0 - 1 + tid; rsl[tid] = ROW_RS(rw < 0 ? 0 : (rw < T ? rw : T - 1)); }
                __syncthreads();
                if (tid >= 352) continue;
                float rp = rsl[0], rc = rsl[1];
                u32x4 gp = (r0 & (SEQ - 1)) ? *(const u32x4*)(Gt + (size_t)(r0 - 1) * 2816 + ch) : z4;
                u32x4 gc = *(const u32x4*)(Gt + (size_t)r0 * 2816 + ch);
                for (int rr = 0; rr < 128; rr += 4) {
                    u32x4 gn[4], uu[4];
#pragma unroll
                    for (int k = 0; k < 4; ++k) {
                        const int row = r0 + rr + k;
                        gn[k] = ((row + 1) & (SEQ - 1)) ? *(const u32x4*)(Gt + (size_t)(row + 1) * 2816 + ch) : z4;
                        uu[k] = *(const u32x4*)(U + (size_t)row * 2816 + ch);
                    }
                    float rn[4];
#pragma unroll
                    for (int k = 0; k < 4; ++k) rn[k] = rsl[rr + k + 2];
#pragma unroll
                    for (int k = 0; k < 4; ++k) {
                        const int row = r0 + rr + k;
                        const unsigned gpw[4] = {gp.x, gp.y, gp.z, gp.w}, gcw[4] = {gc.x, gc.y, gc.z, gc.w}, gnw[4] = {gn[k].x, gn[k].y, gn[k].z, gn[k].w}, uw[4] = {uu[k].x, uu[k].y, uu[k].z, uu[k].w};
                        unsigned ow[4];
#pragma unroll
                        for (int d = 0; d < 4; ++d) {
                            const int hh = d >> 1, e0 = (d & 1) * 2;
                            const float a0 = bflo(gpw[d]) * rp * w0[hh][e0] + bflo(gcw[d]) * rc * w1[hh][e0] + bflo(gnw[d]) * rn[k] * w2[hh][e0] + cb[hh][e0];
                            const float a1 = bfhi(gpw[d]) * rp * w0[hh][e0 + 1] + bfhi(gcw[d]) * rc * w1[hh][e0 + 1] + bfhi(gnw[d]) * rn[k] * w2[hh][e0 + 1] + cb[hh][e0 + 1];
                            ow[d] = cvt_pk_bf16(a0 * sigmoidf_(a0) * (bflo(uw[d]) * rc), a1 * sigmoidf_(a1) * (bfhi(uw[d]) * rc));
                        }
                        *(u32x4*)(U + (size_t)row * 2816 + ch) = (u32x4){ow[0], ow[1], ow[2], ow[3]};
                        gp = gc; gc = gn[k]; rp = rc; rc = rn[k];
                    }
                }
            }
        }
    }
    GRID_SYNC();
    {
        pg8::StaticOrder S; S.init(T, 1024, G, c);
        EpiRes<1> E; E.base = ws + O_HB2; E.HB = (bf16_t*)(ws + O_HB3); E.ssp = (float*)(ws + O_SSP4);
        pg8::gemm_phase(lds, pg8::Gemm{(const bf16_t*)(ws + O_U), (const bf16_t*)(ws + O_WDN), T, 1024, 2816, 2816, 2816}, S, E);
    }
    GRID_SYNC();
    if (STOP_AFTER == 10) return;
    {
        const bf16_t* HB3 = (const bf16_t*)(ws + O_HB3); const float* ssp = (const float*)(ws + O_SSP4);
        int tid_ = threadIdx.x; asm volatile("" : "+v"(tid_));
        const int lane = tid_ & 63, w = tid_ >> 6;
        for (int r = (c * 8 + w) * 2; r < T; r += G * 16) {
            u32x4 hv[2][2]; float rs[2];
#pragma unroll
            for (int k = 0; k < 2; ++k) {
#pragma unroll
                for (int i = 0; i < 2; ++i) hv[k][i] = *(const u32x4*)(HB3 + (size_t)(r + k) * 1024 + (i * 64 + lane) * 8);
                const f32x4* q = (const f32x4*)(ssp + (size_t)(r + k) * 16); const f32x4 t = (q[0] + q[1]) + (q[2] + q[3]);
                rs[k] = rsqrtf(((t[0] + t[1]) + (t[2] + t[3])) * (1.0f / 1024.0f) + 1e-6f);
            }
#pragma unroll
            for (int k = 0; k < 2; ++k)
#pragma unroll
                for (int i = 0; i < 2; ++i) {
                    const int col = (i * 64 + lane) * 8;
                    const f32x4 g0 = *(const f32x4*)(p.final_norm + col), g1 = *(const f32x4*)(p.final_norm + col + 4);
                    const u32x4 v = hv[k][i];
                    f32x4 o0, o1;
                    o0[0] = bflo(v.x) * rs[k] * g0[0]; o0[1] = bfhi(v.x) * rs[k] * g0[1]; o0[2] = bflo(v.y) * rs[k] * g0[2]; o0[3] = bfhi(v.y) * rs[k] * g0[3];
                    o1[0] = bflo(v.z) * rs[k] * g1[0]; o1[1] = bfhi(v.z) * rs[k] * g1[1]; o1[2] = bflo(v.w) * rs[k] * g1[2]; o1[3] = bfhi(v.w) * rs[k] * g1[3];
                    *(f32x4*)(p.out + (size_t)(r + k) * 1024 + col) = o0; *(f32x4*)(p.out + (size_t)(r + k) * 1024 + col + 4) = o1;
                }
        }
    }
}

extern "C" void kernel_launch(void* const* d_in, const int* in_sizes, int n_in, void* d_out, int out_size, void* d_ws, size_t ws_size,
                              hipStream_t stream) {
    constexpr size_t kDynLds = 143360;
    static int grid_blocks = 0;
    if (!grid_blocks) {
        int dev = 0, cus = 0, per_cu = 0;
        hipGetDevice(&dev);
        hipDeviceGetAttribute(&cus, hipDeviceAttributeMultiprocessorCount, dev);
        hipFuncSetAttribute((const void*)mk_kernel, hipFuncAttributeMaxDynamicSharedMemorySize, (int)kDynLds);
        hipOccupancyMaxActiveBlocksPerMultiprocessor(&per_cu, mk_kernel, 512, kDynLds);
        if (per_cu < 1) per_cu = 1;
        grid_blocks = cus * per_cu;
        if (grid_blocks > 256) grid_blocks = 256;
    }
    Params p; memset(&p, 0, sizeof(p));
    p.x = (const float*)d_in[0]; p.mem = (const float*)d_in[1]; p.positions = (const int*)d_in[2];
    const float* norm_mix = (const float*)d_in[3]; const float* w_in = (const float*)d_in[4];
    p.lower_bounds = (const float*)d_in[5]; p.hg_norm = (const float*)d_in[6]; p.sink = (const float*)d_in[7];
    const float* w_br_rec = (const float*)d_in[8]; const float* w_br_att = (const float*)d_in[9]; const float* w_mix_out = (const float*)d_in[10];
    const float* norm_mem = (const float*)d_in[11]; const float* norm_mem_kv = (const float*)d_in[12];
    const float* w_mem_q = (const float*)d_in[13]; const float* w_mem_kv = (const float*)d_in[14]; const float* w_mem_o = (const float*)d_in[15];
    const float* norm_ffn = (const float*)d_in[16]; const float* w_up = (const float*)d_in[17];
    p.conv_w = (const float*)d_in[18]; p.conv_b = (const float*)d_in[19];
    const float* w_down = (const float*)d_in[20]; p.final_norm = (const float*)d_in[21];
    p.out = (float*)d_out; p.ws = (unsigned char*)d_ws;
    for (int i = 0; i < 8; ++i) p.inv_freq[i] = std::pow(500000.0, -(double)i / 8.0);
    int t0 = 0;
    auto job = [&](int idx, const float* src, const float* gain, size_t off, int K, int N, int ldo, int koff, float scale) {
        TJob& j = p.jobs[idx]; j.src = src; j.gain = gain; j.dst_off = (unsigned long long)off; j.K = K; j.N = N; j.ldo = ldo; j.koff = koff; j.scale = scale; j.tile0 = t0;
        t0 += (K / 64) * (N / 256);
    };
    job(0, w_in, norm_mix, O_WIN, 1024, 5376, 1024, 0, 1.0f);
    job(1, w_mem_kv, norm_mem_kv, O_WMKV, 1024, 2048, 1024, 0, 1.0f);
    job(2, w_up, norm_ffn, O_WUP, 1024, 5632, 1024, 0, 1.0f);
    job(3, w_down, nullptr, O_WDN, 2816, 1024, 2816, 0, 1.0f);
    job(4, w_br_rec, nullptr, O_WMID, 512, 1024, 1024, 0, 1.0f);
    job(5, w_br_att, nullptr, O_WMID, 512, 1024, 1024, 512, 1.0f);
    job(6, w_mix_out, nullptr, O_WOUT, 1024, 1024, 1024, 0, 1.0f);
    job(7, w_mem_q, norm_mem, O_WMQ, 1024, 1024, 1024, 0, 0.0625f);
    job(8, w_mem_o, nullptr, O_WMO, 1024, 1024, 1024, 0, 1.0f);
    p.njobs = 9; p.ntiles = t0;
    hipMemsetAsync((unsigned char*)d_ws + O_BAR, 0, XCD_BAR_WORDS * 4, stream);
    void* args[] = {&p};
    hipError_t e = hipLaunchCooperativeKernel((const void*)mk_kernel, dim3(grid_blocks), dim3(512), args, kDynLds, stream);
    if (e != hipSuccess) fprintf(stderr, "cooperative launch failed: %s (grid %d)\n", hipGetErrorString(e), grid_blocks);
}
```

```cpp
#include <hip/hip_runtime.h>
#include <hip/hip_cooperative_groups.h>
#include <cstdio>
#include <cstring>
#include <cmath>
namespace cg = cooperative_groups;

#define LAS __attribute__((address_space(3)))
typedef unsigned short bf16_t;
typedef short bf16x8 __attribute__((ext_vector_type(8)));
typedef short s16x4 __attribute__((ext_vector_type(4)));
typedef float f32x4 __attribute__((ext_vector_type(4)));
typedef float f32x2 __attribute__((ext_vector_type(2)));
typedef unsigned u32x4 __attribute__((ext_vector_type(4)));
typedef unsigned u32x2 __attribute__((ext_vector_type(2)));
typedef _Float16 h16x4 __attribute__((ext_vector_type(4)));
typedef _Float16 h16x8 __attribute__((ext_vector_type(8)));

constexpr int T = 32768, SEQ = 4096;
constexpr size_t MiB = 1u << 20;
constexpr size_t O_WIN = 0;
constexpr size_t O_WMID = O_WIN + 5376ull * 1024 * 2;
constexpr size_t O_WOUT = O_WMID + 2 * MiB;
constexpr size_t O_WMQ = O_WOUT + 2 * MiB;
constexpr size_t O_WMKV = O_WMQ + 2 * MiB;
constexpr size_t O_WMO = O_WMKV + 4 * MiB;
constexpr size_t O_WUP = O_WMO + 2 * MiB;
constexpr size_t O_WDN = O_WUP + 11 * MiB;
constexpr size_t O_RSTD1 = 40 * MiB;
constexpr size_t O_SS2 = O_RSTD1 + 131072;
constexpr size_t O_SS3 = O_SS2 + 131072;
constexpr size_t O_SS4 = O_SS3 + 131072;
constexpr size_t O_RSTDM = O_SS4 + 131072;
constexpr size_t O_LBT = O_RSTDM + 8192;
constexpr size_t O_BAR = 40 * MiB + 768 * 1024;
constexpr size_t O_CS = 41 * MiB;
constexpr size_t O_KVM = 43 * MiB;
constexpr size_t O_MEMB = 51 * MiB;
constexpr size_t O_XB = 56 * MiB;
constexpr size_t O_OF = 56 * MiB, O_OB = 88 * MiB;
constexpr size_t O_QH = 120 * MiB, O_KKF = 152 * MiB, O_KKB = 184 * MiB, O_VH = 216 * MiB, O_SG = 248 * MiB;
constexpr size_t O_QA = 280 * MiB, O_KA = 312 * MiB, O_VA = 320 * MiB;
constexpr size_t O_OA = 328 * MiB;
constexpr size_t O_MERGED = 392 * MiB;
constexpr size_t O_QB = 392 * MiB, O_SMID = 424 * MiB;
constexpr size_t O_HB1 = 120 * MiB, O_QM = 184 * MiB, O_OM = 248 * MiB, O_HB2 = 56 * MiB;
constexpr size_t O_U = 120 * MiB, O_G = 296 * MiB;
constexpr size_t O_SSP2 = 472 * MiB, O_SSP3 = 474 * MiB, O_SSP4 = 476 * MiB;
constexpr size_t O_HB3 = 296 * MiB;

__device__ __forceinline__ float bf2f(unsigned short b) { return __uint_as_float(((unsigned)b) << 16); }
__device__ __forceinline__ float bflo(unsigned w) { return __uint_as_float(w << 16); }
__device__ __forceinline__ float bfhi(unsigned w) { return __uint_as_float(w & 0xffff0000u); }
typedef __bf16 bf16x2_t __attribute__((ext_vector_type(2)));
__device__ __forceinline__ unsigned cvt_pk_bf16(float lo, float hi) { const f32x2 v = {lo, hi}; return __builtin_bit_cast(unsigned, __builtin_convertvector(v, bf16x2_t)); }
__device__ __forceinline__ float sigmoidf_(float x) { return __builtin_amdgcn_rcpf(1.0f + __expf(-x)); }
__device__ __forceinline__ u32x2 pack4(f32x4 v) { u32x2 w; w.x = cvt_pk_bf16(v[0], v[1]); w.y = cvt_pk_bf16(v[2], v[3]); return w; }

struct TJob { const float* src; const float* gain; unsigned long long dst_off; int K, N, ldo, koff; float scale; int tile0; };

struct Params {
    const float* x; const float* mem; const int* positions; const float* lower_bounds; const float* hg_norm; const float* sink;
    const float* conv_w; const float* conv_b; const float* final_norm;
    float* out; unsigned char* ws;
    double inv_freq[8];
    TJob jobs[9];
    int njobs; int ntiles;
};

namespace pg8 {
constexpr int BM = 256, BK = 64, HALF = 128, HTB = HALF * BK * 2, STAGE_BYTES = 8 * HTB, NXCD = 8, WGM = 8;
__host__ __device__ __forceinline__ int lds_byte(int r, int c) { const int st = (r >> 4) * 2 + (c >> 5), rr = r & 15, cc = c & 31, ob = rr * 64 + cc * 2; return st * 1024 + (ob ^ (((ob >> 9) & 1) << 5)); }
__host__ __device__ __forceinline__ void stage_rc(int b, int& R, int& C) { const int st = b / 1024, sb = b % 1024, swz = sb ^ (((sb >> 9) & 1) << 5); R = (st >> 1) * 16 + swz / 64; C = (st & 1) * 32 + (swz % 64) / 2; }
__host__ __device__ __forceinline__ int perm32(int rho) { const int n = rho >> 4, i = rho & 15; return 8 * (i >> 2) + 4 * n + (i & 3); }
struct Unit { int pm, pn; };
struct Gemm { const bf16_t* A; const bf16_t* Bt; int M, N, K, lda, ldb; };
struct StaticOrder {
    int nM, nN, nwg, G, c;
    __host__ __device__ void init(int M, int N, int G_, int c_) { nM = M / BM; nN = N / BM; nwg = nM * nN; G = G_; c = c_; }
    __host__ __device__ bool next(int i, Unit& u) const {
        const long L = (long)i * G + c; if (L >= nwg) return false;
        int wgid = (int)L; { const int q = nwg / NXCD, r = nwg % NXCD, xcd = wgid % NXCD, off = wgid / NXCD; wgid = (xcd < r ? xcd * (q + 1) : r * (q + 1) + (xcd - r) * q) + off; }
        const int nig = WGM * nN, gid = wgid / nig, fm = gid * WGM, gsz = (nM - fm) < WGM ? (nM - fm) : WGM;
        u.pm = fm + ((wgid % nig) % gsz); u.pn = (wgid % nig) / gsz; return true;
    }
    __device__ __forceinline__ void a_ready(const Unit&) const {}
    __device__ __forceinline__ void done(const Unit&) const {}
};

template <class Epi, class Sched>
__device__ __forceinline__ void gemm_phase(LAS unsigned char* lds, const Gemm g, const Sched& S, const Epi& E) {
    int tid = threadIdx.x; asm volatile("" : "+v"(tid));
    const int wid = __builtin_amdgcn_readfirstlane(tid >> 6), lane = tid & 63, wr = wid >> 2, wc = wid & 3, fr = lane & 15, fq = lane >> 4;
    const int K = g.K, nt = K / BK;
    unsigned voffA[2], voffB[2];
#pragma unroll
    for (int i = 0; i < 2; ++i) { int R, C; stage_rc(tid * 16 + i * 8192, R, C); const int Rb = Epi::PERM ? ((R & ~31) + perm32(R & 31)) : R;
        voffA[i] = (unsigned)(R * g.lda + C) * 2u; voffB[i] = (unsigned)(Rb * g.ldb + C) * 2u; }
    const size_t kstep = (size_t)(BK * 2);
    const size_t hstepA = (size_t)HALF * g.lda * 2, hstepB = (size_t)HALF * g.ldb * 2;
    const size_t tstepA = 2 * hstepA, tstepB = 2 * hstepB;
    const unsigned ldsw = (unsigned)wid * 1024u;
    const int aoff = lds_byte(wr * 64 + fr, fq * 8), boff = lds_byte(wc * 32 + fr, fq * 8);
#define PG8_SA(b, h) (((b) * 2 + (h)) * HTB)
#define PG8_SB(b, h) ((4 + (b) * 2 + (h)) * HTB)
#define PG8_STAGE(bufoff, gbase, voff) do { _Pragma("unroll") for (int _i = 0; _i < 2; ++_i) \
        __builtin_amdgcn_global_load_lds((const unsigned*)((const char*)(gbase) + (voff)[_i]), (LAS unsigned*)(lds + (bufoff) + ldsw + _i * 8192), 16, 0, 0); } while (0)
#define PG8_LDA(dst, b, h) do { _Pragma("unroll") for (int m = 0; m < 4; ++m) _Pragma("unroll") for (int k = 0; k < 2; ++k) dst[m][k] = *(const LAS bf16x8*)(lds + PG8_SA(b, h) + aoff + m * 2048 + k * 1024); } while (0)
#define PG8_LDB(dst, b, h) do { _Pragma("unroll") for (int n = 0; n < 2; ++n) _Pragma("unroll") for (int k = 0; k < 2; ++k) dst[n][k] = *(const LAS bf16x8*)(lds + PG8_SB(b, h) + boff + n * 2048 + k * 1024); } while (0)
#define PG8_MMA(ai, bj, At, Bt) do { __builtin_amdgcn_s_setprio(1); _Pragma("unroll") for (int m = 0; m < 4; ++m) _Pragma("unroll") for (int n = 0; n < 2; ++n) _Pragma("unroll") for (int k = 0; k < 2; ++k) \
        acc[ai][bj][m][n] = __builtin_amdgcn_mfma_f32_16x16x32_bf16(Bt[n][k], At[m][k], acc[ai][bj][m][n], 0, 0, 0); __builtin_amdgcn_s_setprio(0); } while (0)
#define PG8_WAIT_V(n) asm volatile("s_waitcnt vmcnt(" #n ")" ::: "memory")
#define PG8_WAIT_L(n) asm volatile("s_waitcnt lgkmcnt(" #n ")" ::: "memory")
#define PG8_BAR __builtin_amdgcn_s_barrier()
#define PG8_SCHED __builtin_amdgcn_sched_barrier(0)
    Unit cur, nxt; int ui = 0;
    if (!S.next(0, cur)) return;
    f32x4 acc[2][2][4][2];
#pragma unroll
    for (int a = 0; a < 2; ++a)
#pragma unroll
        for (int b = 0; b < 2; ++b)
#pragma unroll
            for (int m = 0; m < 4; ++m)
#pragma unroll
                for (int n = 0; n < 2; ++n) acc[a][b][m][n] = (f32x4){0.f, 0.f, 0.f, 0.f};
    bf16x8 At[4][2], B0[2][2], B1[2][2];
    const char* cA = (const char*)g.A + (size_t)cur.pm * tstepA; const char* cB = (const char*)g.Bt + (size_t)cur.pn * tstepB;
    S.a_ready(cur);
    PG8_STAGE(PG8_SB(0, 0), cB, voffB); PG8_STAGE(PG8_SA(0, 0), cA, voffA); PG8_STAGE(PG8_SB(0, 1), cB + hstepB, voffB); PG8_STAGE(PG8_SA(0, 1), cA + hstepA, voffA);
    if (wr == 1) PG8_BAR;
    PG8_WAIT_V(4); PG8_BAR;
    PG8_STAGE(PG8_SB(1, 0), cB + kstep, voffB); PG8_STAGE(PG8_SA(1, 0), cA + kstep, voffA); PG8_STAGE(PG8_SB(1, 1), cB + hstepB + kstep, voffB);
    PG8_WAIT_V(6); PG8_BAR;
    for (;;) {
        const bool has_next = S.next(ui + 1, nxt);
        const char* nA = has_next ? (const char*)g.A + (size_t)nxt.pm * tstepA : cA; const char* nB = has_next ? (const char*)g.Bt + (size_t)nxt.pn * tstepB : cB;
        for (int t = 0; t < nt; t += 2) {
            const bool last = (t == nt - 2);
            if constexpr (Epi::HAS_MID) { if (t == nt / 2) E.mid(acc, cur, wr, wc, fr, fq); }
            const char* a1 = cA + (size_t)(t + 1) * kstep;
            const char* a2 = last ? nA : cA + (size_t)(t + 2) * kstep; const char* b2 = last ? nB : cB + (size_t)(t + 2) * kstep;
            const char* a3 = a2 + kstep; const char* b3 = b2 + kstep;
            if (last && has_next) S.a_ready(nxt);
            PG8_LDB(B0, 0, 0); PG8_SCHED; PG8_LDA(At, 0, 0); PG8_STAGE(PG8_SA(1, 1), a1 + hstepA, voffA);
            PG8_WAIT_L(8); PG8_BAR; PG8_WAIT_L(0); PG8_MMA(0, 0, At, B0); PG8_BAR; PG8_SCHED;
            PG8_LDB(B1, 0, 1); PG8_STAGE(PG8_SB(0, 0), b2, voffB);
            PG8_BAR; PG8_WAIT_L(0); PG8_MMA(0, 1, At, B1); PG8_BAR;
            PG8_LDA(At, 0, 1); PG8_STAGE(PG8_SA(0, 0), a2, voffA);
            PG8_BAR; PG8_WAIT_L(0); PG8_MMA(1, 0, At, B0); PG8_BAR; PG8_SCHED;
            PG8_STAGE(PG8_SB(0, 1), b2 + hstepB, voffB);
            PG8_WAIT_V(6); PG8_BAR; PG8_MMA(1, 1, At, B1); PG8_BAR;
            PG8_LDB(B0, 1, 0); PG8_SCHED; PG8_LDA(At, 1, 0); PG8_STAGE(PG8_SA(0, 1), a2 + hstepA, voffA);
            PG8_WAIT_L(8); PG8_BAR; PG8_WAIT_L(0); PG8_MMA(0, 0, At, B0); PG8_BAR; PG8_SCHED;
            PG8_LDB(B1, 1, 1); PG8_STAGE(PG8_SB(1, 0), b3, voffB);
            PG8_BAR; PG8_WAIT_L(0); PG8_MMA(0, 1, At, B1); PG8_BAR;
            PG8_LDA(At, 1, 1); PG8_STAGE(PG8_SA(1, 0), a3, voffA);
            PG8_BAR; PG8_WAIT_L(0); PG8_MMA(1, 0, At, B0); PG8_BAR; PG8_SCHED;
            PG8_STAGE(PG8_SB(1, 1), b3 + hstepB, voffB);
            PG8_WAIT_V(6); PG8_BAR; PG8_MMA(1, 1, At, B1); PG8_BAR;
        }
        E(acc, cur, wr, wc, fr, fq); S.done(cur);
        if (!has_next) break;
#pragma unroll
        for (int a = 0; a < 2; ++a)
#pragma unroll
            for (int b = 0; b < 2; ++b)
#pragma unroll
                for (int m = 0; m < 4; ++m)
#pragma unroll
                    for (int n = 0; n < 2; ++n) acc[a][b][m][n] = (f32x4){0.f, 0.f, 0.f, 0.f};
        cur = nxt; cA = nA; cB = nB; ++ui;
    }
    PG8_WAIT_V(0);
    if (wr == 0) PG8_BAR;
    PG8_BAR;
#undef PG8_SA
#undef PG8_SB
#undef PG8_STAGE
#undef PG8_LDA
#undef PG8_LDB
#undef PG8_MMA
#undef PG8_WAIT_V
#undef PG8_WAIT_L
#undef PG8_BAR
#undef PG8_SCHED
}
}

#define EPI_LOOP_ROWS _Pragma("unroll") for (int ai = 0; ai < 2; ++ai) _Pragma("unroll") for (int m = 0; m < 4; ++m)
#define EPI_LOOP_COLS _Pragma("unroll") for (int bj = 0; bj < 2; ++bj) _Pragma("unroll") for (int n = 0; n < 2; ++n)

struct EpiProj {
    static constexpr bool PERM = true, HAS_MID = false;
    const float* rstd; const float* lbt; const float* cs;
    bf16_t *QH, *VH, *SG, *QA, *KA, *VA, *GR, *GA; _Float16 *KKF, *KKB;
    template <int MODE>
    __device__ __forceinline__ void run(const f32x4 (&acc)[2][2][4][2], const pg8::Unit& u, int wr, int wc, int fr, int fq) const {
        const int pn = u.pn;
        EPI_LOOP_ROWS {
            const int row = u.pm * 256 + ai * 128 + wr * 64 + m * 16 + fr;
#pragma unroll
            for (int bj = 0; bj < 2; ++bj) {
                const int col = pn * 256 + bj * 128 + wc * 32 + 8 * fq;
                f32x4 v0 = acc[ai][bj][m][0], v1 = acc[ai][bj][m][1];
                if (MODE == 0) {
#pragma unroll
                    for (int i = 0; i < 4; ++i) { v0[i] = v0[i] * sigmoidf_(v0[i]) * 0.08838834764831845f; v1[i] = v1[i] * sigmoidf_(v1[i]) * 0.08838834764831845f; }
                    const u32x2 lo = pack4(v0), hi = pack4(v1);
                    *(u32x4*)(QH + (size_t)row * 512 + col) = (u32x4){lo.x, lo.y, hi.x, hi.y};
                } else if (MODE == 1 || MODE == 2) {
                    const int c = col - (MODE == 1 ? 512 : 1024);
                    const f32x4 lb0 = *(const f32x4*)(lbt + (MODE == 1 ? 0 : 512) + c), lb1 = *(const f32x4*)(lbt + (MODE == 1 ? 0 : 512) + c + 4);
                    h16x8 o;
#pragma unroll
                    for (int i = 0; i < 4; ++i) {
                        o[i] = (_Float16)__log2f(1.0f - (1.0f - lb0[i]) * __builtin_amdgcn_rcpf(1.0f + __expf(v0[i])));
                        o[4 + i] = (_Float16)__log2f(1.0f - (1.0f - lb1[i]) * __builtin_amdgcn_rcpf(1.0f + __expf(v1[i])));
                    }
                    *(h16x8*)((MODE == 1 ? KKF : KKB) + (size_t)row * 512 + c) = o;
                } else if (MODE == 3) {
                    const u32x2 lo = pack4(v0), hi = pack4(v1);
                    *(u32x4*)(VH + (size_t)row * 512 + (col - 1536)) = (u32x4){lo.x, lo.y, hi.x, hi.y};
                } else if (MODE == 4) {
#pragma unroll
                    for (int i = 0; i < 4; ++i) { v0[i] = v0[i] * sigmoidf_(v0[i]); v1[i] = v1[i] * sigmoidf_(v1[i]); }
                    const u32x2 lo = pack4(v0), hi = pack4(v1);
                    *(u32x4*)(SG + (size_t)row * 512 + (col - 2048)) = (u32x4){lo.x, lo.y, hi.x, hi.y};
                } else if (MODE == 5 || MODE == 6) {
                    const bool rot = ((wc & 1) == 0) && (MODE == 5 || bj == 0);
                    if (rot) {
                        f32x4 p0, p1;
#pragma unroll
                        for (int i = 0; i < 4; ++i) { p0[i] = __shfl_xor(v0[i], 16); p1[i] = __shfl_xor(v1[i], 16); }
                        const f32x4 c0 = *(const f32x4*)(cs + (size_t)row * 16), c1 = *(const f32x4*)(cs + (size_t)row * 16 + 4);
                        const f32x4 s0 = *(const f32x4*)(cs + (size_t)row * 16 + 8), s1 = *(const f32x4*)(cs + (size_t)row * 16 + 12);
                        const f32x4 r0a = v0 * c0 - p0 * s0, r1a = v1 * c1 - p1 * s1, r0b = v0 * c0 + p0 * s0, r1b = v1 * c1 + p1 * s1;
                        v0 = (fq == 0) ? r0a : ((fq == 1) ? r0b : v0); v1 = (fq == 0) ? r1a : ((fq == 1) ? r1b : v1);
                    }
                    if (MODE == 5) { v0 = v0 * 0.125f; v1 = v1 * 0.125f; }
                    const u32x2 lo = pack4(v0), hi = pack4(v1); const u32x4 w = (u32x4){lo.x, lo.y, hi.x, hi.y};
                    if (MODE == 5) *(u32x4*)(QA + (size_t)row * 512 + (col - 2560)) = w;
                    else if (bj == 0) *(u32x4*)(KA + (size_t)row * 128 + (col - 3072)) = w;
                    else *(u32x4*)(VA + (size_t)row * 128 + (col - 3200)) = w;
                } else {
#pragma unroll
                    for (int i = 0; i < 4; ++i) { v0[i] = sigmoidf_(v0[i]); v1[i] = sigmoidf_(v1[i]); }
                    const u32x2 lo = pack4(v0), hi = pack4(v1); const u32x4 w = (u32x4){lo.x, lo.y, hi.x, hi.y};
                    if (MODE == 7) *(u32x4*)(GR + (size_t)row * 1024 + (col - 3328)) = w;
                    else *(u32x4*)(GA + (size_t)row * 1024 + (col - 4352)) = w;
                }
            }
        }
    }
    __device__ __forceinline__ void operator()(const f32x4 (&acc)[2][2][4][2], const pg8::Unit& u, int wr, int wc, int fr, int fq) const {
        const int pn = u.pn;
        if (pn < 2) run<0>(acc, u, wr, wc, fr, fq);
        else if (pn < 4) run<1>(acc, u, wr, wc, fr, fq);
        else if (pn < 6) run<2>(acc, u, wr, wc, fr, fq);
        else if (pn < 8) run<3>(acc, u, wr, wc, fr, fq);
        else if (pn < 10) run<4>(acc, u, wr, wc, fr, fq);
        else if (pn < 12) run<5>(acc, u, wr, wc, fr, fq);
        else if (pn == 12) run<6>(acc, u, wr, wc, fr, fq);
        else if (pn < 17) run<7>(acc, u, wr, wc, fr, fq);
        else run<8>(acc, u, wr, wc, fr, fq);
    }
};

__device__ __forceinline__ void epi_membar() { asm volatile("" ::: "memory"); }
template <int MODE>
struct EpiScale {
    static constexpr bool PERM = (MODE != 0), HAS_MID = false;
    const float* rs; bf16_t* O; int ldo; bf16_t* O2; int split;
    __device__ __forceinline__ void operator()(const f32x4 (&acc)[2][2][4][2], const pg8::Unit& u, int wr, int wc, int fr, int fq) const {
        bf16_t* base = O; int cb = u.pn * 256;
        if (cb >= split) { base = O2; cb -= split; }
        EPI_LOOP_ROWS {
            const int row = u.pm * 256 + ai * 128 + wr * 64 + m * 16 + fr;
            float s;
            if (MODE == 0) s = rs[row];
            else if (MODE == 2) s = 1.0f;
            else { const f32x4* q = (const f32x4*)(rs + (size_t)row * 16); const f32x4 t = (q[0] + q[1]) + (q[2] + q[3]); s = rsqrtf(((t[0] + t[1]) + (t[2] + t[3])) * (1.0f / 1024.0f) + 1e-6f); }
            if constexpr (PERM) {
#pragma unroll
                for (int bj = 0; bj < 2; ++bj) {
                    const int col = cb + bj * 128 + wc * 32 + 8 * fq;
                    const u32x2 lo = pack4(acc[ai][bj][m][0] * s), hi = pack4(acc[ai][bj][m][1] * s);
                    *(u32x4*)(base + (size_t)row * ldo + col) = (u32x4){lo.x, lo.y, hi.x, hi.y};
                }
                epi_membar();
            } else {
                EPI_LOOP_COLS {
                    const int col = cb + bj * 128 + wc * 32 + n * 16 + 4 * fq;
                    *(u32x2*)(base + (size_t)row * ldo + col) = pack4(acc[ai][bj][m][n] * s);
                }
            }
        }
    }
};

struct EpiMergeFused {
    static constexpr bool PERM = true, HAS_MID = true;
    const bf16_t* GR; const bf16_t* GA; bf16_t* O;
    __device__ __forceinline__ void mid(f32x4 (&acc)[2][2][4][2], const pg8::Unit& u, int wr, int wc, int fr, int fq) const {
        asm volatile("" : "+v"(fr), "+v"(fq));
#pragma unroll
        for (int ai = 0; ai < 2; ++ai)
#pragma unroll
            for (int m = 0; m < 4; ++m) {
                const int row = u.pm * 256 + ai * 128 + wr * 64 + m * 16 + fr;
#pragma unroll
                for (int bj = 0; bj < 2; ++bj) {
                    const int col = u.pn * 256 + bj * 128 + wc * 32 + 8 * fq;
                    const u32x4 r = *(const u32x4*)(GR + (size_t)row * 1024 + col), a = *(const u32x4*)(GA + (size_t)row * 1024 + col);
                    f32x4 f0, f1;
                    f0[0] = bflo(r.x) * __builtin_amdgcn_rcpf(fmaxf(bflo(a.x), 1e-30f)); f0[1] = bfhi(r.x) * __builtin_amdgcn_rcpf(fmaxf(bfhi(a.x), 1e-30f));
                    f0[2] = bflo(r.y) * __builtin_amdgcn_rcpf(fmaxf(bflo(a.y), 1e-30f)); f0[3] = bfhi(r.y) * __builtin_amdgcn_rcpf(fmaxf(bfhi(a.y), 1e-30f));
                    f1[0] = bflo(r.z) * __builtin_amdgcn_rcpf(fmaxf(bflo(a.z), 1e-30f)); f1[1] = bfhi(r.z) * __builtin_amdgcn_rcpf(fmaxf(bfhi(a.z), 1e-30f));
                    f1[2] = bflo(r.w) * __builtin_amdgcn_rcpf(fmaxf(bflo(a.w), 1e-30f)); f1[3] = bfhi(r.w) * __builtin_amdgcn_rcpf(fmaxf(bfhi(a.w), 1e-30f));
                    acc[ai][bj][m][0] = acc[ai][bj][m][0] * f0; acc[ai][bj][m][1] = acc[ai][bj][m][1] * f1;
                }
                if (m == 3) epi_membar();
            }
    }
    __device__ __forceinline__ void operator()(const f32x4 (&acc)[2][2][4][2], const pg8::Unit& u, int wr, int wc, int fr, int fq) const {
        EPI_LOOP_ROWS {
            const int row = u.pm * 256 + ai * 128 + wr * 64 + m * 16 + fr;
#pragma unroll
            for (int bj = 0; bj < 2; ++bj) {
                const int col = u.pn * 256 + bj * 128 + wc * 32 + 8 * fq;
                const u32x4 a = *(const u32x4*)(GA + (size_t)row * 1024 + col);
                f32x4 f0, f1; f0[0] = bflo(a.x); f0[1] = bfhi(a.x); f0[2] = bflo(a.y); f0[3] = bfhi(a.y); f1[0] = bflo(a.z); f1[1] = bfhi(a.z); f1[2] = bflo(a.w); f1[3] = bfhi(a.w);
                const u32x2 lo = pack4(acc[ai][bj][m][0] * f0), hi = pack4(acc[ai][bj][m][1] * f1);
                *(u32x4*)(O + (size_t)row * 1024 + col) = (u32x4){lo.x, lo.y, hi.x, hi.y};
            }
        }
    }
};

template <int BASE_BF16>
struct EpiRes {
    static constexpr bool PERM = true, HAS_MID = false;
    const void* base; bf16_t* HB; float* ssp;
    __device__ __forceinline__ void operator()(const f32x4 (&acc)[2][2][4][2], const pg8::Unit& u, int wr, int wc, int fr, int fq) const {
        EPI_LOOP_ROWS {
            const int row = u.pm * 256 + ai * 128 + wr * 64 + m * 16 + fr;
            float sq = 0.f;
#pragma unroll
            for (int bj = 0; bj < 2; ++bj) {
                const int col = u.pn * 256 + bj * 128 + wc * 32 + 8 * fq;
                f32x4 h0, h1;
                if (BASE_BF16) { const u32x4 b = *(const u32x4*)((const bf16_t*)base + (size_t)row * 1024 + col);
                    h0[0] = bflo(b.x); h0[1] = bfhi(b.x); h0[2] = bflo(b.y); h0[3] = bfhi(b.y); h1[0] = bflo(b.z); h1[1] = bfhi(b.z); h1[2] = bflo(b.w); h1[3] = bfhi(b.w); }
                else { h0 = *(const f32x4*)((const float*)base + (size_t)row * 1024 + col); h1 = *(const f32x4*)((const float*)base + (size_t)row * 1024 + col + 4); }
                h0 = h0 + acc[ai][bj][m][0]; h1 = h1 + acc[ai][bj][m][1];
                const u32x2 lo = pack4(h0), hi = pack4(h1);
                *(u32x4*)(HB + (size_t)row * 1024 + col) = (u32x4){lo.x, lo.y, hi.x, hi.y};
                sq += (h0[0] * h0[0] + h0[1] * h0[1] + h0[2] * h0[2] + h0[3] * h0[3]) + (h1[0] * h1[0] + h1[1] * h1[1] + h1[2] * h1[2] + h1[3] * h1[3]);
            }
            sq += __shfl_xor(sq, 16); sq += __shfl_xor(sq, 32);
            if (fq == 0) ssp[(size_t)row * 16 + u.pn * 4 + wc] = sq;
        }
    }
};

__device__ __forceinline__ void rownorm_bf16_x2(const float* H, bf16_t* HB, int row, int lane) {
    const f32x4* s0 = (const f32x4*)(H + (size_t)row * 1024); const f32x4* s1 = s0 + 256;
    f32x4 v0[4], v1[4]; float a0 = 0.f, a1 = 0.f;
#pragma unroll
    for (int i = 0; i < 4; ++i) { v0[i] = s0[i * 64 + lane]; v1[i] = s1[i * 64 + lane]; }
#pragma unroll
    for (int i = 0; i < 4; ++i) { a0 += v0[i][0] * v0[i][0] + v0[i][1] * v0[i][1] + v0[i][2] * v0[i][2] + v0[i][3] * v0[i][3]; a1 += v1[i][0] * v1[i][0] + v1[i][1] * v1[i][1] + v1[i][2] * v1[i][2] + v1[i][3] * v1[i][3]; }
#pragma unroll
    for (int o = 32; o >= 1; o >>= 1) { a0 += __shfl_xor(a0, o); a1 += __shfl_xor(a1, o); }
    const float r0 = rsqrtf(a0 * (1.0f / 1024.0f) + 1e-6f), r1 = rsqrtf(a1 * (1.0f / 1024.0f) + 1e-6f);
#pragma unroll
    for (int i = 0; i < 4; ++i) { *(u32x2*)(HB + (size_t)row * 1024 + (i * 64 + lane) * 4) = pack4(v0[i] * r0); *(u32x2*)(HB + (size_t)(row + 1) * 1024 + (i * 64 + lane) * 4) = pack4(v1[i] * r1); }
}

__device__ __forceinline__ void transpose_tile(const TJob& j, bf16_t* dst, int tile, LAS float* tl) {
    const int tid = threadIdx.x;
    const int ntn = j.N / 256; const int tk = tile / ntn, tn = tile % ntn; const int k0 = tk * 64, n0 = tn * 256;
    {
        const int r = tid >> 6, c4 = (tid & 63) * 4;
        f32x4 v[8];
#pragma unroll
        for (int ps = 0; ps < 8; ++ps) v[ps] = __builtin_nontemporal_load((const f32x4*)(j.src + (size_t)(k0 + r + 8 * ps) * j.N + n0 + c4));
#pragma unroll
        for (int ps = 0; ps < 8; ++ps) {
            const float g = j.gain ? j.gain[k0 + r + 8 * ps] * j.scale : j.scale;
            LAS float* t = tl + (r + 8 * ps) * 257 + c4;
            t[0] = v[ps][0] * g; t[1] = v[ps][1] * g; t[2] = v[ps][2] * g; t[3] = v[ps][3] * g;
        }
    }
    __syncthreads();
    {
        const int n = tid >> 1, kh = (tid & 1) * 32;
#pragma unroll
        for (int q = 0; q < 4; ++q) {
            const int kc = kh + 8 * q;
            u32x4 w;
            w.x = cvt_pk_bf16(tl[(kc + 0) * 257 + n], tl[(kc + 1) * 257 + n]); w.y = cvt_pk_bf16(tl[(kc + 2) * 257 + n], tl[(kc + 3) * 257 + n]);
            w.z = cvt_pk_bf16(tl[(kc + 4) * 257 + n], tl[(kc + 5) * 257 + n]); w.w = cvt_pk_bf16(tl[(kc + 6) * 257 + n], tl[(kc + 7) * 257 + n]);
            *(u32x4*)(dst + (size_t)(n0 + n) * j.ldo + j.koff + k0 + kc) = w;
        }
    }
    __syncthreads();
}

__device__ __forceinline__ void rowprep2(const float* src, bf16_t* dst, float* rstd, int row, int lane) {
    const f32x4* s0 = (const f32x4*)(src + (size_t)row * 1024); const f32x4* s1 = s0 + 256;
    f32x4 v0[4], v1[4]; float a0 = 0.f, a1 = 0.f;
#pragma unroll
    for (int i = 0; i < 4; ++i) { v0[i] = __builtin_nontemporal_load(s0 + i * 64 + lane); v1[i] = __builtin_nontemporal_load(s1 + i * 64 + lane); }
#pragma unroll
    for (int i = 0; i < 4; ++i) {
        a0 += v0[i][0] * v0[i][0] + v0[i][1] * v0[i][1] + v0[i][2] * v0[i][2] + v0[i][3] * v0[i][3];
        a1 += v1[i][0] * v1[i][0] + v1[i][1] * v1[i][1] + v1[i][2] * v1[i][2] + v1[i][3] * v1[i][3];
    }
#pragma unroll
    for (int o = 32; o >= 1; o >>= 1) { a0 += __shfl_xor(a0, o); a1 += __shfl_xor(a1, o); }
    const float r0 = rsqrtf(a0 * (1.0f / 1024.0f) + 1e-6f), r1 = rsqrtf(a1 * (1.0f / 1024.0f) + 1e-6f);
#pragma unroll
    for (int i = 0; i < 4; ++i) { *(u32x2*)(dst + (size_t)row * 1024 + (i * 64 + lane) * 4) = pack4(v0[i] * r0); *(u32x2*)(dst + (size_t)(row + 1) * 1024 + (i * 64 + lane) * 4) = pack4(v1[i] * r1); }
}

__device__ __forceinline__ void phase_prep(const Params& p, LAS unsigned char* lds, const int tr_lo, const int tr_hi, const bool rest, const int bid, const int nb) {
    const int tid = threadIdx.x, lane = tid & 63, w = tid >> 6;
    unsigned char* ws = p.ws;
    const int n_tr = tr_hi - tr_lo, n_x = T / 16, n_m = 2048 / 16, n_z = 0, n_cs = T * 8 / 512, n_lb = 2;
    const int total = rest ? n_tr + n_x + n_m + n_z + n_cs + n_lb : n_tr;
    for (int it = bid; it < total; it += nb) {
        int i = it;
        if (i < n_tr) {
            i += tr_lo;
            int jb = 0;
#pragma unroll
            for (int q = 1; q < 9; ++q) if (i >= p.jobs[q].tile0) jb = q;
            transpose_tile(p.jobs[jb], (bf16_t*)(ws + p.jobs[jb].dst_off), i - p.jobs[jb].tile0, (LAS float*)lds);
            continue;
        }
        i -= n_tr;
        if (i < n_x) { rowprep2(p.x, (bf16_t*)(ws + O_XB), (float*)(ws + O_RSTD1), (i * 8 + w) * 2, lane); continue; }
        i -= n_x;
        if (i < n_m) { rowprep2(p.mem, (bf16_t*)(ws + O_MEMB), (float*)(ws + O_RSTDM), (i * 8 + w) * 2, lane); continue; }
        i -= n_m;
        if (i < n_z) { ((float*)(ws + O_SS2))[i * 512 + tid] = 0.f; continue; }
        i -= n_z;
        if (i < n_cs) {
            const int idx = i * 512 + tid, row = idx >> 3, fi = idx & 7;
            const double xr = (double)p.positions[row] * p.inv_freq[fi] * 0.15915494309189535;
            const float fr = (float)(xr - rint(xr));
            float* cs = (float*)(ws + O_CS);
            cs[(size_t)row * 16 + fi] = __builtin_amdgcn_cosf(fr); cs[(size_t)row * 16 + 8 + fi] = __builtin_amdgcn_sinf(fr);
            continue;
        }
        i -= n_cs;
        {
            const int idx = i * 512 + tid, d = idx >> 9, k = idx & 511;
            const float a0 = p.lower_bounds[d * 1024 + k], a1 = p.lower_bounds[d * 1024 + 512 + k];
            ((float*)(ws + O_LBT))[idx] = 1.0f / (1.0f + __expf(a1 - a0));
        }
    }
}

__device__ __forceinline__ s16x4 lds_tr(const LAS bf16_t* ptr) { return __builtin_amdgcn_ds_read_tr16_b64_v4i16((LAS s16x4*)ptr); }
__device__ __forceinline__ bf16x8 cat44(s16x4 a, s16x4 b) { bf16x8 r; r[0] = a[0]; r[1] = a[1]; r[2] = a[2]; r[3] = a[3]; r[4] = b[0]; r[5] = b[1]; r[6] = b[2]; r[7] = b[3]; return r; }

__device__ __forceinline__ void hgrn_item(const Params& p, int item, LAS unsigned char* lds) {
    const int tid = threadIdx.x, lane = tid & 63, w = tid >> 6, l15 = lane & 15, q4 = lane >> 4;
    const int sgi = item & 1, chain = item >> 1, dir = chain & 1, h = (chain >> 1) & 3, b = chain >> 3;
    unsigned char* ws = p.ws;
    bf16_t* QB = (bf16_t*)(ws + O_QB); float* SM = (float*)(ws + O_SMID);
    float btot = 0.f;
    const _Float16* LF = (const _Float16*)(ws + (dir ? O_KKB : O_KKF));
    const bf16_t* QH = (const bf16_t*)(ws + O_QH); const bf16_t* VH = (const bf16_t*)(ws + O_VH);
    bf16_t* O = (bf16_t*)(ws + (dir ? O_OB : O_OF));
    LAS bf16_t* Ps = (LAS bf16_t*)(lds + 106496);
    LAS float* seg = (LAS float*)(lds + 115712);
#define HG_QM(bf_) ((LAS bf16_t*)(lds + (bf_) * 53248))
#define HG_KM(bf_) ((LAS bf16_t*)(lds + (bf_) * 53248 + 17408))
#define HG_VS(bf_) ((LAS bf16_t*)(lds + (bf_) * 53248 + 34816))
#define HG_EMID(bf_) ((LAS float*)(lds + (bf_) * 53248 + 52224))
#define HG_E2(bf_) ((LAS float*)(lds + (bf_) * 53248 + 52224 + 512))
    const int kc = tid & 127, sg = tid >> 7;
    const size_t rb = (size_t)b * SEQ; const int hc = h * 128;
    f32x4 S[8];
#pragma unroll
    for (int i = 0; i < 8; ++i) S[i] = (f32x4){0.f, 0.f, 0.f, 0.f};
    _Float16 lfv[16]; bf16_t qv[16]; u32x4 rv[2];
    f32x4 oacc[4];
#define HG_ROW(g) (rb + (size_t)(dir ? (SEQ - 1 - (g)) : (g)))
    const long rstep = dir ? -512 : 512;
    const int c0 = 32 * sgi, c1 = c0 + 32;
#define HG_PREFETCH(ci) do { \
        { const size_t o_ = HG_ROW((ci) * 64 + sg * 16) * 512 + hc + kc; const _Float16* lp_ = LF + o_; const bf16_t* qp_ = QH + o_; \
          _Pragma("unroll") for (int j = 0; j < 16; ++j) { lfv[j] = lp_[j * rstep]; qv[j] = qp_[j * rstep]; } } \
        _Pragma("unroll") for (int e = 0; e < 2; ++e) { const int c_ = tid + 512 * e; const size_t r_ = HG_ROW((ci) * 64 + (c_ >> 4)); rv[e] = *(const u32x4*)(VH + r_ * 512 + hc + (c_ & 15) * 8); } } while (0)
#define HG_PREP_A() do { float run = 0.f; _Pragma("unroll") for (int j = 0; j < 16; ++j) run += (float)lfv[j]; seg[sg * 128 + kc] = run; } while (0)
#define HG_PREP_B(cidx, bf_) do { \
        LAS bf16_t* Qm_ = HG_QM(bf_); LAS bf16_t* Km_ = HG_KM(bf_); LAS bf16_t* Vs_ = HG_VS(bf_); \
        const float s0 = seg[kc], s1 = seg[128 + kc], s2 = seg[256 + kc], s3 = seg[384 + kc]; \
        const float bmid = s0 + s1, bend = bmid + s2 + s3; \
        const float pre = (sg > 0 ? s0 : 0.f) + (sg > 1 ? s1 : 0.f) + (sg > 2 ? s2 : 0.f) - bmid; \
        const float ek = sgi ? __builtin_amdgcn_exp2f(btot + bmid) : 0.f; \
        bf16_t* qbp = QB + HG_ROW((cidx) * 64 + sg * 16) * 512 + hc + kc; \
        float run_ = pre, eip_ = 0.f; \
        _Pragma("unroll") for (int j = 0; j < 16; ++j) { \
            run_ += (float)lfv[j]; \
            const float d = fminf(fmaxf(run_, -86.f), 86.f);                      \
            const float e = __builtin_amdgcn_exp2f(d), ei = __builtin_amdgcn_rcpf(e); \
            const float fj = (j == 0) ? __builtin_amdgcn_exp2f((float)lfv[0]) : e * eip_;        \
            eip_ = ei; \
            const float qm = bf2f(qv[j]) * e, km = (1.0f - fj) * ei; \
            const int r = sg * 16 + j; \
            Qm_[r * 136 + kc] = (bf16_t)(cvt_pk_bf16(qm, 0.f) & 0xffffu); Km_[r * 136 + kc] = (bf16_t)(cvt_pk_bf16(km, 0.f) & 0xffffu); \
            if (sgi) qbp[j * rstep] = (bf16_t)(cvt_pk_bf16(qm * ek, 0.f) & 0xffffu); \
        } \
        btot += bend; \
        if (sg == 0) { HG_EMID(bf_)[kc] = __builtin_amdgcn_exp2f(bmid); HG_E2(bf_)[kc] = __builtin_amdgcn_exp2f(bend - bmid); } \
        _Pragma("unroll") for (int e = 0; e < 2; ++e) { const int c_ = tid + 512 * e; *(LAS u32x4*)(Vs_ + (c_ >> 4) * 136 + (c_ & 15) * 8) = rv[e]; } \
        if ((cidx) + 1 < c1) HG_PREFETCH((cidx) + 1); \
    } while (0)
#define HG_COMP_C(bf_) do { \
        const LAS bf16_t* Qm_ = HG_QM(bf_); const LAS bf16_t* Km_ = HG_KM(bf_); const LAS float* em_ = HG_EMID(bf_); \
        { const int tt = w >> 1; \
          f32x4 sc0 = (f32x4){0.f, 0.f, 0.f, 0.f}, sc1 = sc0; \
          const LAS bf16_t* qa = Qm_ + (16 * tt + l15) * 136 + 8 * q4; \
          const LAS bf16_t* kb = Km_ + (32 * (w & 1) + l15) * 136 + 8 * q4; \
          _Pragma("unroll") for (int ks = 0; ks < 4; ++ks) { \
              const bf16x8 a = *(const LAS bf16x8*)(qa + 32 * ks); \
              sc0 = __builtin_amdgcn_mfma_f32_16x16x32_bf16(a, *(const LAS bf16x8*)(kb + 32 * ks), sc0, 0, 0, 0); \
              sc1 = __builtin_amdgcn_mfma_f32_16x16x32_bf16(a, *(const LAS bf16x8*)(kb + 16 * 136 + 32 * ks), sc1, 0, 0, 0); } \
          _Pragma("unroll") for (int r = 0; r < 4; ++r) { \
              const int t = 16 * tt + 4 * q4 + r, s_0 = 32 * (w & 1) + l15, s_1 = s_0 + 16; \
              Ps[t * 72 + s_0] = (bf16_t)(cvt_pk_bf16(s_0 <= t ? sc0[r] : 0.f, 0.f) & 0xffffu); \
              Ps[t * 72 + s_1] = (bf16_t)(cvt_pk_bf16(s_1 <= t ? sc1[r] : 0.f, 0.f) & 0xffffu); } } \
        _Pragma("unroll") for (int i = 0; i < 4; ++i) oacc[i] = (f32x4){0.f, 0.f, 0.f, 0.f}; \
        _Pragma("unroll") for (int i = 0; i < 4; ++i) { \
            S[2 * i] = S[2 * i] * *(const LAS f32x4*)(em_ + 32 * i + 4 * q4); S[2 * i + 1] = S[2 * i + 1] * *(const LAS f32x4*)(em_ + 32 * i + 16 + 4 * q4); \
            u32x4 bw; bw.x = cvt_pk_bf16(S[2 * i][0], S[2 * i][1]); bw.y = cvt_pk_bf16(S[2 * i][2], S[2 * i][3]); bw.z = cvt_pk_bf16(S[2 * i + 1][0], S[2 * i + 1][1]); bw.w = cvt_pk_bf16(S[2 * i + 1][2], S[2 * i + 1][3]); \
            const bf16x8 sb = __builtin_bit_cast(bf16x8, bw); \
            _Pragma("unroll") for (int tt = 0; tt < 4; ++tt) { \
                const LAS bf16_t* qa = Qm_ + (16 * tt + l15) * 136 + 32 * i + 4 * q4; \
                const u32x2 lo = *(const LAS u32x2*)qa, hi = *(const LAS u32x2*)(qa + 16); \
                u32x4 aw; aw.x = lo.x; aw.y = lo.y; aw.z = hi.x; aw.w = hi.y; \
                oacc[tt] = __builtin_amdgcn_mfma_f32_16x16x32_bf16(__builtin_bit_cast(bf16x8, aw), sb, oacc[tt], 0, 0, 0); } } \
    } while (0)
#define HG_COMP_D(cidx, bf_) do { \
        const LAS bf16_t* Km_ = HG_KM(bf_); const LAS bf16_t* Vs_ = HG_VS(bf_); const LAS float* e2_ = HG_E2(bf_); \
        bf16x8 vb[2]; \
        _Pragma("unroll") for (int i = 0; i < 2; ++i) { \
            const LAS bf16_t* va = Vs_ + (32 * i + 8 * q4 + (l15 >> 2)) * 136 + 16 * w + 4 * (l15 & 3); \
            vb[i] = cat44(lds_tr(va), lds_tr(va + 4 * 136)); } \
        _Pragma("unroll") for (int tt = 0; tt < 4; ++tt) \
            _Pragma("unroll") for (int i = 0; i < 2; ++i) { \
                if (32 * i > 16 * tt + 15) continue; \
                const bf16x8 pa = *(const LAS bf16x8*)(Ps + (16 * tt + l15) * 72 + 32 * i + 8 * q4); \
                oacc[tt] = __builtin_amdgcn_mfma_f32_16x16x32_bf16(pa, vb[i], oacc[tt], 0, 0, 0); } \
        bf16_t* op = O + HG_ROW((cidx) * 64 + 4 * q4) * 512 + hc + 16 * w + l15; \
        _Pragma("unroll") for (int tt = 0; tt < 4; ++tt) \
            _Pragma("unroll") for (int r = 0; r < 4; ++r) op[(16 * tt + r) * rstep] = (bf16_t)(cvt_pk_bf16(oacc[tt][r], 0.f) & 0xffffu); \
        _Pragma("unroll") for (int kt = 0; kt < 8; ++kt) { \
            _Pragma("unroll") for (int i = 0; i < 2; ++i) { \
                const LAS bf16_t* ka = Km_ + (32 * i + 8 * q4 + (l15 >> 2)) * 136 + 16 * kt + 4 * (l15 & 3); \
                S[kt] = __builtin_amdgcn_mfma_f32_16x16x32_bf16(cat44(lds_tr(ka), lds_tr(ka + 4 * 136)), vb[i], S[kt], 0, 0, 0); } \
            S[kt] = S[kt] * *(const LAS f32x4*)(e2_ + 16 * kt + 4 * q4); } \
    } while (0)
    HG_PREFETCH(c0);
    HG_PREP_A();
    __syncthreads();
    HG_PREP_B(c0, 0);
    __syncthreads();
    HG_PREP_A();
    __syncthreads();
    for (int ci = c0; ci < c1; ++ci) {
        const int bf = (ci - c0) & 1;
        const bool more = ci + 1 < c1, more2 = ci + 2 < c1;
        if (bf == 0) { if (more) HG_PREP_B(ci + 1, 1); HG_COMP_C(0); } else { if (more) HG_PREP_B(ci + 1, 0); HG_COMP_C(1); }
        __syncthreads();
        if (bf == 0) HG_COMP_D(ci, 0); else HG_COMP_D(ci, 1);
        if (more2) HG_PREP_A();
        __syncthreads();
    }
#undef HG_PREP_A
#undef HG_PREP_B
#undef HG_COMP_C
#undef HG_COMP_D
#undef HG_QM
#undef HG_KM
#undef HG_VS
#undef HG_EMID
#undef HG_E2
    if (sgi == 0) {
#pragma unroll
        for (int kt = 0; kt < 8; ++kt) *(f32x4*)(SM + ((size_t)chain * 128 + 16 * w + l15) * 128 + 16 * kt + 4 * q4) = S[kt];
    }
#undef HG_PREFETCH
}

__device__ __forceinline__ void hgrn_carry_item(const Params& p, int item, LAS unsigned char* lds, int& staged_chain) {
    const int tid = threadIdx.x, lane = tid & 63, w = tid >> 6, l15 = lane & 15, q4 = lane >> 4;
    const int tile = item & 15, chain = item >> 4, dir = chain & 1, h = (chain >> 1) & 3, b = chain >> 3;
    unsigned char* ws = p.ws;
    const bf16_t* QB = (const bf16_t*)(ws + O_QB); const float* SM = (const float*)(ws + O_SMID);
    bf16_t* O = (bf16_t*)(ws + (dir ? O_OB : O_OF));
    LAS bf16_t* Sm = (LAS bf16_t*)lds;
    if (staged_chain != chain) {
        __syncthreads();
        const int v = tid >> 2, kq = (tid & 3) * 32;
        const float* sp = SM + ((size_t)chain * 128 + v) * 128 + kq;
        f32x4 t[8];
#pragma unroll
        for (int e = 0; e < 8; ++e) t[e] = *(const f32x4*)(sp + 4 * e);
#pragma unroll
        for (int e = 0; e < 4; ++e) { const u32x2 lo = pack4(t[2 * e]), hi = pack4(t[2 * e + 1]); *(LAS u32x4*)(Sm + v * 136 + kq + 8 * e) = (u32x4){lo.x, lo.y, hi.x, hi.y}; }
        __syncthreads();
        staged_chain = chain;
    }
    const size_t rb = (size_t)b * SEQ; const int hc = h * 128;
    const int g0 = SEQ / 2 + tile * 128 + w * 16;
    bf16x8 qa[4];
#pragma unroll
    for (int ks = 0; ks < 4; ++ks) qa[ks] = *(const bf16x8*)(QB + HG_ROW(g0 + l15) * 512 + hc + 32 * ks + 8 * q4);
#pragma unroll
    for (int vt = 0; vt < 8; ++vt) {
        f32x4 acc = (f32x4){0.f, 0.f, 0.f, 0.f};
        const LAS bf16_t* sp = Sm + (16 * vt + l15) * 136 + 8 * q4;
#pragma unroll
        for (int ks = 0; ks < 4; ++ks) acc = __builtin_amdgcn_mfma_f32_16x16x32_bf16(qa[ks], *(const LAS bf16x8*)(sp + 32 * ks), acc, 0, 0, 0);
#pragma unroll
        for (int r = 0; r < 4; ++r) {
            bf16_t* op = O + HG_ROW(g0 + 4 * q4 + r) * 512 + hc + 16 * vt + l15;
            *op = (bf16_t)(cvt_pk_bf16(bf2f(*op) + acc[r], 0.f) & 0xffffu);
        }
    }
}
#undef HG_ROW

__device__ __forceinline__ void wattn_item(const Params& p, int item, LAS unsigned char* lds) {
    const int tid = threadIdx.x, lane = tid & 63, w = tid >> 6, l15 = lane & 15, q4 = lane >> 4;
    const int qh = item & 7, nb = (item >> 3) & 31, b = item >> 8, hk = qh >> 2;
    unsigned char* ws = p.ws;
    const bf16_t* QA = (const bf16_t*)(ws + O_QA); const bf16_t* KA = (const bf16_t*)(ws + O_KA); const bf16_t* VA = (const bf16_t*)(ws + O_VA);
    bf16_t* OA = (bf16_t*)(ws + O_OA);
    LAS bf16_t* Ks = (LAS bf16_t*)lds; LAS bf16_t* Vs = Ks + 400 * 72;
    {
        u32x4 sk[7], sv[7];
#pragma unroll
        for (int e = 0; e < 7; ++e) {
            const int r = (tid >> 3) + 64 * e, ch = (tid & 7) * 8; const int tok = (nb - 1) * 128 + r;
            sk[e] = (u32x4){0u, 0u, 0u, 0u}; sv[e] = sk[e];
            if (r < 384 && tok >= 0 && tok < SEQ) { const size_t row = (size_t)b * SEQ + tok; sk[e] = *(const u32x4*)(KA + row * 128 + hk * 64 + ch); sv[e] = *(const u32x4*)(VA + row * 128 + hk * 64 + ch); }
        }
#pragma unroll
        for (int e = 0; e < 7; ++e) {
            const int r = (tid >> 3) + 64 * e, ch = (tid & 7) * 8;
            if (r < 400) { *(LAS u32x4*)(Ks + r * 72 + ch) = sk[e]; *(LAS u32x4*)(Vs + r * 72 + ch) = sv[e]; }
        }
    }
    __syncthreads();
    const size_t qrow = (size_t)b * SEQ + nb * 128 + w * 16 + l15;
    const bf16x8 bq0 = *(const bf16x8*)(QA + qrow * 512 + qh * 64 + 8 * q4), bq1 = *(const bf16x8*)(QA + qrow * 512 + qh * 64 + 32 + 8 * q4);
    f32x4 sc[18];
#pragma unroll
    for (int s = 0; s < 18; ++s) {
        const LAS bf16_t* kr = Ks + (16 * (w + s) + l15) * 72 + 8 * q4;
        const bf16x8 a0 = *(const LAS bf16x8*)kr, a1 = *(const LAS bf16x8*)(kr + 32);
        f32x4 z = (f32x4){0.f, 0.f, 0.f, 0.f};
        z = __builtin_amdgcn_mfma_f32_16x16x32_bf16(a0, bq0, z, 0, 0, 0);
        sc[s] = __builtin_amdgcn_mfma_f32_16x16x32_bf16(a1, bq1, z, 0, 0, 0);
        if ((s & 3) == 3) __builtin_amdgcn_sched_barrier(0);
    }
    const int tq = 16 * w + l15;
    const int lo = max(tq, (1 - nb) * 128), hi = min(tq + 256, SEQ - 1 - (nb - 1) * 128);
    const int sl0 = 16 * w + 4 * q4;
    float mx = -1e30f;
#pragma unroll
    for (int s = 0; s < 18; ++s)
#pragma unroll
        for (int r = 0; r < 4; ++r) {
            const int sl = sl0 + 16 * s + r;
            const int neg = ((sl - lo) | (hi - sl)) >> 31;
            const float v = sc[s][r] + __uint_as_float((unsigned)neg & 0xF149F2CAu);
            sc[s][r] = v; mx = fmaxf(mx, v);
        }
    mx = fmaxf(mx, __shfl_xor(mx, 16)); mx = fmaxf(mx, __shfl_xor(mx, 32));
    const float sk = p.sink[qh]; mx = fmaxf(mx, sk);
    float sum = 0.f;
#pragma unroll
    for (int s = 0; s < 18; ++s)
#pragma unroll
        for (int r = 0; r < 4; ++r) { const float e = __expf(sc[s][r] - mx); sc[s][r] = e; sum += e; }
    sum += __shfl_xor(sum, 16); sum += __shfl_xor(sum, 32);
    sum += __expf(sk - mx);
    const float inv = 1.0f / sum;
    f32x4 oc[4];
#pragma unroll
    for (int d = 0; d < 4; ++d) oc[d] = (f32x4){0.f, 0.f, 0.f, 0.f};
#pragma unroll
    for (int i = 0; i < 9; ++i) {
        u32x4 pw; pw.x = cvt_pk_bf16(sc[2 * i][0] * inv, sc[2 * i][1] * inv); pw.y = cvt_pk_bf16(sc[2 * i][2] * inv, sc[2 * i][3] * inv);
        pw.z = cvt_pk_bf16(sc[2 * i + 1][0] * inv, sc[2 * i + 1][1] * inv); pw.w = cvt_pk_bf16(sc[2 * i + 1][2] * inv, sc[2 * i + 1][3] * inv);
        const bf16x8 pa = __builtin_bit_cast(bf16x8, pw);
        const LAS bf16_t* vb = Vs + (16 * (w + 2 * i) + 4 * q4 + (l15 >> 2)) * 72 + 4 * (l15 & 3);
#pragma unroll
        for (int d = 0; d < 4; ++d) {
            const s16x4 v0 = lds_tr(vb + 16 * d), v1 = lds_tr(vb + 16 * 72 + 16 * d);
            bf16x8 bv; bv[0] = v0[0]; bv[1] = v0[1]; bv[2] = v0[2]; bv[3] = v0[3]; bv[4] = v1[0]; bv[5] = v1[1]; bv[6] = v1[2]; bv[7] = v1[3];
            oc[d] = __builtin_amdgcn_mfma_f32_16x16x32_bf16(pa, bv, oc[d], 0, 0, 0);
        }
        __builtin_amdgcn_sched_barrier(0);
    }
    const size_t orow = (size_t)b * SEQ + nb * 128 + w * 16 + 4 * q4;
#pragma unroll
    for (int d = 0; d < 4; ++d)
#pragma unroll
        for (int r = 0; r < 4; ++r) OA[(orow + r) * 1024 + 512 + qh * 64 + 16 * d + l15] = (bf16_t)(cvt_pk_bf16(oc[d][r], 0.f) & 0xffffu);
    __syncthreads();
}

__device__ __forceinline__ void hgrn_combine_row(const Params& p, int row, int lane) {
    unsigned char* ws = p.ws;
    const u32x4 a = *(const u32x4*)((const bf16_t*)(ws + O_OF) + (size_t)row * 512 + lane * 8), c = *(const u32x4*)((const bf16_t*)(ws + O_OB) + (size_t)row * 512 + lane * 8);
    const u32x4 g = *(const u32x4*)((const bf16_t*)(ws + O_SG) + (size_t)row * 512 + lane * 8);
    float o[8];
    o[0] = bflo(a.x) + bflo(c.x); o[1] = bfhi(a.x) + bfhi(c.x); o[2] = bflo(a.y) + bflo(c.y); o[3] = bfhi(a.y) + bfhi(c.y);
    o[4] = bflo(a.z) + bflo(c.z); o[5] = bfhi(a.z) + bfhi(c.z); o[6] = bflo(a.w) + bflo(c.w); o[7] = bfhi(a.w) + bfhi(c.w);
    float ss = 0.f;
#pragma unroll
    for (int i = 0; i < 8; ++i) ss += o[i] * o[i];
    ss += __shfl_xor(ss, 1); ss += __shfl_xor(ss, 2); ss += __shfl_xor(ss, 4); ss += __shfl_xor(ss, 8);
    const float rs = rsqrtf(ss * (1.0f / 128.0f) + 1e-6f);
    const f32x4 n0 = *(const f32x4*)(p.hg_norm + lane * 8), n1 = *(const f32x4*)(p.hg_norm + lane * 8 + 4);
    u32x4 w;
    w.x = cvt_pk_bf16(o[0] * rs * n0[0] * bflo(g.x), o[1] * rs * n0[1] * bfhi(g.x)); w.y = cvt_pk_bf16(o[2] * rs * n0[2] * bflo(g.y), o[3] * rs * n0[3] * bfhi(g.y));
    w.z = cvt_pk_bf16(o[4] * rs * n1[0] * bflo(g.z), o[5] * rs * n1[1] * bfhi(g.z)); w.w = cvt_pk_bf16(o[6] * rs * n1[2] * bflo(g.w), o[7] * rs * n1[3] * bfhi(g.w));
    *(u32x4*)((bf16_t*)(ws + O_OA) + (size_t)row * 1024 + lane * 8) = w;
}

__device__ __forceinline__ void mattn_item(const Params& p, int item, LAS unsigned char* lds) {
    const int tid = threadIdx.x, lane = tid & 63, w = tid >> 6, l15 = lane & 15, q4 = lane >> 4;
    const int qt = item & 31, hd = (item >> 5) & 3, b = item >> 7;
    unsigned char* ws = p.ws;
    const bf16_t* QM = (const bf16_t*)(ws + O_QM); const bf16_t* KVM = (const bf16_t*)(ws + O_KVM); bf16_t* OM = (bf16_t*)(ws + O_OM);
    LAS bf16_t* Ks = (LAS bf16_t*)lds;
#pragma unroll
    for (int hf = 0; hf < 2; ++hf) {
        u32x4 st[8];
#pragma unroll
        for (int e = 0; e < 8; ++e) st[e] = *(const u32x4*)(KVM + (size_t)(b * 256 + (tid >> 5) + 16 * (8 * hf + e)) * 2048 +  hd * 256 + (tid & 31) * 8);
#pragma unroll
        for (int e = 0; e < 8; ++e) *(LAS u32x4*)(Ks + ((tid >> 5) + 16 * (8 * hf + e)) * 264 + (tid & 31) * 8) = st[e];
    }
    __syncthreads();
    const size_t qrow = (size_t)b * SEQ + qt * 128 + w * 16 + l15;
    float rsq;
    { const f32x4* q_ = (const f32x4*)((const float*)(ws + O_SSP2) + qrow * 16); const f32x4 t_ = (q_[0] + q_[1]) + (q_[2] + q_[3]); rsq = rsqrtf(((t_[0] + t_[1]) + (t_[2] + t_[3])) * (1.0f / 1024.0f) + 1e-6f); }
    bf16x8 bq[8];
#pragma unroll
    for (int d = 0; d < 8; ++d) bq[d] = *(const bf16x8*)(QM + qrow * 1024 + hd * 256 + d * 32 + 8 * q4);
    f32x4 sc[16];
#pragma unroll
    for (int s = 0; s < 16; ++s) {
        const LAS bf16_t* kr = Ks + (16 * s + l15) * 264 + 8 * q4;
        f32x4 z = (f32x4){0.f, 0.f, 0.f, 0.f};
#pragma unroll
        for (int d = 0; d < 8; ++d) z = __builtin_amdgcn_mfma_f32_16x16x32_bf16(*(const LAS bf16x8*)(kr + 32 * d), bq[d], z, 0, 0, 0);
        sc[s] = z;
        if (s & 1) __builtin_amdgcn_sched_barrier(0);
    }
    float mx = -1e30f;
#pragma unroll
    for (int s = 0; s < 16; ++s)
#pragma unroll
        for (int r = 0; r < 4; ++r) mx = fmaxf(mx, sc[s][r]);
    mx = fmaxf(mx, __shfl_xor(mx, 16)); mx = fmaxf(mx, __shfl_xor(mx, 32));
    float sum = 0.f;
#pragma unroll
    for (int s = 0; s < 16; ++s)
#pragma unroll
        for (int r = 0; r < 4; ++r) { const float e = __expf((sc[s][r] - mx) * rsq); sc[s][r] = e; sum += e; }
    sum += __shfl_xor(sum, 16); sum += __shfl_xor(sum, 32);
    const float inv = 1.0f / sum;
    bf16x8 pa[8];
#pragma unroll
    for (int i = 0; i < 8; ++i) {
        u32x4 pw; pw.x = cvt_pk_bf16(sc[2 * i][0] * inv, sc[2 * i][1] * inv); pw.y = cvt_pk_bf16(sc[2 * i][2] * inv, sc[2 * i][3] * inv);
        pw.z = cvt_pk_bf16(sc[2 * i + 1][0] * inv, sc[2 * i + 1][1] * inv); pw.w = cvt_pk_bf16(sc[2 * i + 1][2] * inv, sc[2 * i + 1][3] * inv);
        pa[i] = __builtin_bit_cast(bf16x8, pw);
    }
    __syncthreads();
#pragma unroll
    for (int hf = 0; hf < 2; ++hf) {
        u32x4 st[8];
#pragma unroll
        for (int e = 0; e < 8; ++e) st[e] = *(const u32x4*)(KVM + (size_t)(b * 256 + (tid >> 5) + 16 * (8 * hf + e)) * 2048 + 1024 + hd * 256 + (tid & 31) * 8);
#pragma unroll
        for (int e = 0; e < 8; ++e) *(LAS u32x4*)(Ks + ((tid >> 5) + 16 * (8 * hf + e)) * 264 + (tid & 31) * 8) = st[e];
    }
    __syncthreads();
    const size_t orow = (size_t)b * SEQ + qt * 128 + w * 16 + 4 * q4;
#pragma unroll
    for (int dh = 0; dh < 2; ++dh) {
        f32x4 oc[8];
#pragma unroll
        for (int d = 0; d < 8; ++d) oc[d] = (f32x4){0.f, 0.f, 0.f, 0.f};
#pragma unroll
        for (int i = 0; i < 8; ++i) {
            const LAS bf16_t* vb = Ks + (32 * i + 4 * q4 + (l15 >> 2)) * 264 + dh * 128 + 4 * (l15 & 3);
#pragma unroll
            for (int d = 0; d < 8; ++d) {
                const s16x4 v0 = lds_tr(vb + 16 * d), v1 = lds_tr(vb + 16 * 264 + 16 * d);
                bf16x8 bv; bv[0] = v0[0]; bv[1] = v0[1]; bv[2] = v0[2]; bv[3] = v0[3]; bv[4] = v1[0]; bv[5] = v1[1]; bv[6] = v1[2]; bv[7] = v1[3];
                oc[d] = __builtin_amdgcn_mfma_f32_16x16x32_bf16(pa[i], bv, oc[d], 0, 0, 0);
            }
            __builtin_amdgcn_sched_barrier(0);
        }
#pragma unroll
        for (int d = 0; d < 8; ++d)
#pragma unroll
            for (int r = 0; r < 4; ++r) OM[(orow + r) * 1024 + hd * 256 + dh * 128 + 16 * d + l15] = (bf16_t)(cvt_pk_bf16(oc[d][r], 0.f) & 0xffffu);
    }
    __syncthreads();
}

#ifndef DBG
#define DBG 0
#endif
#ifndef STOP_AFTER
#define STOP_AFTER 99
#endif
#define XB_TMO      128
#define XB_XCNT(j)  (256  + 64 * (j))
#define XB_XSUB(j)  (1280 + 64 * (j))
#define XB_XGEN(j)  (2304 + 64 * (j))
#define XB_TOP      3328
#define XB_TOPGEN   3392
#define XCD_BAR_WORDS 3456
#define XB_SPIN_CAP (1u << 18)

__device__ __forceinline__ unsigned xb_ld(unsigned* p)              { return __hip_atomic_load(p, __ATOMIC_RELAXED, __HIP_MEMORY_SCOPE_AGENT); }
__device__ __forceinline__ unsigned xb_add(unsigned* p, unsigned v) { return __hip_atomic_fetch_add(p, v, __ATOMIC_RELAXED, __HIP_MEMORY_SCOPE_AGENT); }
__device__ __forceinline__ unsigned xb_xcc_id() { return (unsigned)__builtin_amdgcn_s_getreg((3 << 11) | 20) & 0xFu; }
#define XB_SPIN(cond, bar) do { unsigned _sp = 0; while (cond) { __builtin_amdgcn_s_sleep(1); \
    if ((++_sp & 255u) == 0u) { if (xb_ld(&(bar)[XB_TMO])) break; if (_sp > XB_SPIN_CAP) { atomicAdd(&(bar)[XB_TMO], 1u); break; } } } } while (0)

struct XcdBarrier {
    unsigned* bar; unsigned x;
    volatile LAS unsigned* st;
};

__device__ __forceinline__ XcdBarrier xcd_barrier_post(unsigned* bar, volatile LAS unsigned* st) {
    XcdBarrier b; b.bar = bar; b.x = xb_xcc_id(); b.st = st;
    if (threadIdx.x == 0) (void)xb_add(&bar[XB_XCNT(b.x)], 1u);
    return b;
}
__device__ __forceinline__ void xcd_barrier_complete(unsigned* bar, unsigned x, unsigned& nloc, unsigned& nx) {
    const unsigned G = gridDim.x * gridDim.y * gridDim.z;
    unsigned sum, cnt, mine, sp = 0u;
    for (;;) {
        sum = 0u; cnt = 0u; mine = 0u;
#pragma unroll
        for (unsigned j = 0; j < 16; ++j) { const unsigned c = xb_ld(&bar[XB_XCNT(j)]); sum += c; cnt += (c > 0u) ? 1u : 0u; mine = (j == x) ? c : mine; }
        if (sum == G) break;
        __builtin_amdgcn_s_sleep(1);
        if ((++sp & 255u) == 0u) { if (xb_ld(&bar[XB_TMO])) break; if (sp > XB_SPIN_CAP) { atomicAdd(&bar[XB_TMO], 1u); break; } }
    }
    nloc = mine > 0u ? mine : 1u; nx = cnt > 0u ? cnt : 1u;
}

__device__ __forceinline__ void xcd_barrier(const XcdBarrier& b) {
    asm volatile("s_waitcnt vmcnt(0)" ::: "memory");
    __syncthreads();
    if (threadIdx.x == 0) {
        unsigned* bar = b.bar;
        __builtin_amdgcn_s_waitcnt(0);
        unsigned nloc = b.st[0], nx = b.st[1];
        if (nloc == 0u) { xcd_barrier_complete(bar, b.x, nloc, nx); b.st[0] = nloc; b.st[1] = nx; }
        const unsigned old = xb_add(&bar[XB_XSUB(b.x)], 1u);
        const unsigned gen = old / nloc;
        if (old + 1u == (gen + 1u) * nloc) {
            __builtin_amdgcn_fence(__ATOMIC_RELEASE, "agent");
            asm volatile("s_waitcnt vmcnt(0)" ::: "memory");
            const unsigned og = xb_add(&bar[XB_TOP], 1u);
            const unsigned tg = og / nx;
            if (og + 1u == (tg + 1u) * nx) xb_add(&bar[XB_TOPGEN], 1u);
            else XB_SPIN(xb_ld(&bar[XB_TOPGEN]) == tg, bar);
            __builtin_amdgcn_fence(__ATOMIC_ACQUIRE, "agent");
            xb_add(&bar[XB_XGEN(b.x)], 1u);
            asm volatile("s_waitcnt vmcnt(0)" ::: "memory");
        } else {
            XB_SPIN(xb_ld(&bar[XB_XGEN(b.x)]) == gen, bar);
            __builtin_amdgcn_fence(__ATOMIC_ACQUIRE, "agent");
            asm volatile("s_waitcnt vmcnt(0)" ::: "memory");
        }
    }
    __syncthreads();
}

#define GRID_SYNC() xcd_barrier(xb)
__global__ void __launch_bounds__(512) mk_kernel(Params p) {
    cg::grid_group grid = cg::this_grid();
    extern __shared__ __attribute__((aligned(16))) unsigned char lds_raw[];
    LAS unsigned char* lds = (LAS unsigned char*)lds_raw;
    unsigned char* ws = p.ws;
    const int tid = threadIdx.x, lane = tid & 63, w = tid >> 6;
    const int G = gridDim.x, c = blockIdx.x;

    volatile LAS unsigned* xst = (volatile LAS unsigned*)(lds + 143344);
    if (tid == 0) { xst[0] = 0u; xst[1] = 0u; }
    __syncthreads();
    const XcdBarrier xb = xcd_barrier_post((unsigned*)(ws + O_BAR), xst);
    if (p.njobs < 0) grid.sync();
    phase_prep(p, lds, 0, p.jobs[2].tile0, true, c, G);
    GRID_SYNC();

    {
        pg8::StaticOrder S; S.init(T, 5376, G, c);
        EpiProj E; E.rstd = (const float*)(ws + O_RSTD1); E.lbt = (const float*)(ws + O_LBT); E.cs = (const float*)(ws + O_CS);
        E.QH = (bf16_t*)(ws + O_QH); E.VH = (bf16_t*)(ws + O_VH); E.SG = (bf16_t*)(ws + O_SG); E.QA = (bf16_t*)(ws + O_QA); E.KA = (bf16_t*)(ws + O_KA); E.VA = (bf16_t*)(ws + O_VA);
        E.GR = (bf16_t*)p.out; E.GA = (bf16_t*)p.out + (size_t)T * 1024; E.KKF = (_Float16*)(ws + O_KKF); E.KKB = (_Float16*)(ws + O_KKB);
        pg8::gemm_phase(lds, pg8::Gemm{(const bf16_t*)(ws + O_XB), (const bf16_t*)(ws + O_WIN), T, 5376, 1024, 1024, 1024}, S, E);
        pg8::StaticOrder S2; S2.init(2048, 2048, G, G - 1 - c);
        EpiScale<2> E2; E2.rs = nullptr; E2.O = (bf16_t*)(ws + O_KVM); E2.ldo = 2048; E2.O2 = E2.O; E2.split = 1 << 30;
        pg8::gemm_phase(lds, pg8::Gemm{(const bf16_t*)(ws + O_MEMB), (const bf16_t*)(ws + O_WMKV), 2048, 2048, 1024, 1024, 1024}, S2, E2);
    }
    GRID_SYNC();

    if (DBG == 1) {
        const unsigned short* a0 = (const unsigned short*)(ws + O_QH); const unsigned short* a1 = (const unsigned short*)(ws + O_KKF); const unsigned short* a2 = (const unsigned short*)(ws + O_KKB);
        const unsigned short* a3 = (const unsigned short*)(ws + O_VH); const unsigned short* a4 = (const unsigned short*)(ws + O_SG); const unsigned short* a5 = (const unsigned short*)(ws + O_QA);
        const unsigned short* a6 = (const unsigned short*)(ws + O_KA); const unsigned short* a7 = (const unsigned short*)(ws + O_VA);
        for (size_t idx = (size_t)blockIdx.x * 512 + threadIdx.x; idx < (size_t)T * 1024; idx += (size_t)gridDim.x * 512) {
            const size_t row = idx >> 10; const int c = (int)(idx & 1023), c5 = c & 511, c1 = c & 127; float v;
            if (c < 512) v = bf2f(a0[row * 512 + c5]) + bf2f(a1[row * 512 + c5]) * 0.001f + bf2f(a2[row * 512 + c5]) * 0.001f + bf2f(a3[row * 512 + c5]);
            else v = bf2f(a4[row * 512 + c5]) + bf2f(a5[row * 512 + c5]) + bf2f(a6[row * 128 + c1]) + bf2f(a7[row * 128 + c1]);
            p.out[idx] = v;
        }
        return;
    }
    {
        const int nh = G >= 256 ? 128 : 0;
        if (c < nh || nh == 0) for (int it = c; it < 128; it += (nh ? nh : G)) hgrn_item(p, it, lds);
        if (c >= nh) phase_prep(p, lds, p.jobs[2].tile0, p.ntiles, false, c - nh, G - nh);
        {
            unsigned* qctr = (unsigned*)(ws + O_BAR);
            volatile LAS unsigned* qslot = (volatile LAS unsigned*)(lds + 143352);
            for (;;) {
                __syncthreads();
                if (tid == 0) *qslot = __hip_atomic_fetch_add(qctr, 1u, __ATOMIC_RELAXED, __HIP_MEMORY_SCOPE_AGENT);
                __syncthreads();
                const unsigned it = *qslot;
                if (it >= 2048u) break;
                wattn_item(p, (int)it, lds);
            }
        }
    }
    GRID_SYNC();
    {
        const int per = (1024 + G - 1) / G; int staged = -1;
        for (int it = c * per; it < (c + 1) * per && it < 1024; ++it) hgrn_carry_item(p, it, lds, staged);
        __syncthreads();
    }
    GRID_SYNC();
    for (int r = c * 8 + w; r < T; r += G * 8) hgrn_combine_row(p, r, lane);
    GRID_SYNC();

    if (DBG == 2) {
        const unsigned short* a0 = (const unsigned short*)(ws + O_OA);
        for (size_t idx = (size_t)blockIdx.x * 512 + threadIdx.x; idx < (size_t)T * 1024; idx += (size_t)gridDim.x * 512) p.out[idx] = bf2f(a0[idx]);
        return;
    }
    {
        pg8::StaticOrder S; S.init(T, 1024, G, c);
        EpiMergeFused E; E.GR = (const bf16_t*)p.out; E.GA = (const bf16_t*)p.out + (size_t)T * 1024; E.O = (bf16_t*)(ws + O_MERGED);
        pg8::gemm_phase(lds, pg8::Gemm{(const bf16_t*)(ws + O_OA), (const bf16_t*)(ws + O_WMID), T, 1024, 1024, 1024, 1024}, S, E);
    }
    GRID_SYNC();
    if (DBG == 3) {
        const unsigned short* a0 = (const unsigned short*)(ws + O_MERGED);
        for (size_t idx = (size_t)blockIdx.x * 512 + threadIdx.x; idx < (size_t)T * 1024; idx += (size_t)gridDim.x * 512) p.out[idx] = bf2f(a0[idx]);
        return;
    }
    {
        pg8::StaticOrder S; S.init(T, 1024, G, c);
        EpiRes<0> E; E.base = p.x; E.HB = (bf16_t*)(ws + O_HB1); E.ssp = (float*)(ws + O_SSP2);
        pg8::gemm_phase(lds, pg8::Gemm{(const bf16_t*)(ws + O_MERGED), (const bf16_t*)(ws + O_WOUT), T, 1024, 1024, 1024, 1024}, S, E);
    }
    GRID_SYNC();
    if (STOP_AFTER == 4) return;
    {
        pg8::StaticOrder S; S.init(T, 1024, G, c);
        EpiScale<2> E; E.rs = nullptr; E.O = (bf16_t*)(ws + O_QM); E.ldo = 1024; E.O2 = E.O; E.split = 1 << 30;
        pg8::gemm_phase(lds, pg8::Gemm{(const bf16_t*)(ws + O_HB1), (const bf16_t*)(ws + O_WMQ), T, 1024, 1024, 1024, 1024}, S, E);
        asm volatile("s_waitcnt vmcnt(0)" ::: "memory");
        __syncthreads();
        __builtin_amdgcn_fence(__ATOMIC_ACQUIRE, "agent");
        pg8::Unit u;
        for (int i = 0; S.next(i, u); ++i)
#pragma nounroll
            for (int hq = 0; hq < 2; ++hq) mattn_item(p, ((u.pm >> 4) << 7) | (u.pn << 5) | (2 * (u.pm & 15) + hq), lds);
    }
    GRID_SYNC();
    {
        pg8::StaticOrder S; S.init(T, 1024, G, c);
        EpiRes<1> E; E.base = ws + O_HB1; E.HB = (bf16_t*)(ws + O_HB2); E.ssp = (float*)(ws + O_SSP3);
        pg8::gemm_phase(lds, pg8::Gemm{(const bf16_t*)(ws + O_OM), (const bf16_t*)(ws + O_WMO), T, 1024, 1024, 1024, 1024}, S, E);
    }
    GRID_SYNC();
    if (STOP_AFTER == 7) return;
    {
        pg8::StaticOrder S; S.init(T, 5632, G, c);
        EpiScale<2> E; E.rs = nullptr; E.O = (bf16_t*)(ws + O_U); E.ldo = 2816; E.O2 = (bf16_t*)(ws + O_G); E.split = 2816;
        pg8::gemm_phase(lds, pg8::Gemm{(const bf16_t*)(ws + O_HB2), (const bf16_t*)(ws + O_WUP), T, 5632, 1024, 1024, 1024}, S, E);
    }
    GRID_SYNC();
    {
        bf16_t* U = (bf16_t*)(ws + O_U); const bf16_t* Gt = (const bf16_t*)(ws + O_G);
        {
            const int ch = (tid < 352 ? tid : 0) * 8;
            f32x4 w0[2], w1[2], w2[2], cb[2];
#pragma unroll
            for (int hh = 0; hh < 2; ++hh) { w0[hh] = *(const f32x4*)(p.conv_w + ch + 4 * hh); w1[hh] = *(const f32x4*)(p.conv_w + 2816 + ch + 4 * hh); w2[hh] = *(const f32x4*)(p.conv_w + 5632 + ch + 4 * hh); cb[hh] = *(const f32x4*)(p.conv_b + ch + 4 * hh); }
            const u32x4 z4 = (u32x4){0u, 0u, 0u, 0u};
            const float* ssp3 = (const float*)(ws + O_SSP3);
#define ROW_RS(r_) ({ const f32x4* q_ = (const f32x4*)(ssp3 + (size_t)(r_) * 16); const f32x4 t_ = (q_[0] + q_[1]) + (q_[2] + q_[3]); rsqrtf(((t_[0] + t_[1]) + (t_[2] + t_[3])) * (1.0f / 1024.0f) + 1e-6f); })
            LAS float* rsl = (LAS float*)lds;
            for (int sgm = c; sgm < T / 128; sgm += G) {
                const int r0 = sgm * 128;
                __syncthreads();
                if (tid < 130) { const int rw = r0 - 1 + tid; rsl[tid] = ROW_RS(rw < 0 ? 0 : (rw < T ? rw : T - 1)); }
                __syncthreads();
                if (tid >= 352) continue;
                float rp = rsl[0], rc = rsl[1];
                u32x4 gp = (r0 & (SEQ - 1)) ? *(const u32x4*)(Gt + (size_t)(r0 - 1) * 2816 + ch) : z4;
                u32x4 gc = *(const u32x4*)(Gt + (size_t)r0 * 2816 + ch);
                for (int rr = 0; rr < 128; rr += 4) {
                    u32x4 gn[4], uu[4];
#pragma unroll
                    for (int k = 0; k < 4; ++k) {
                        const int row = r0 + rr + k;
                        gn[k] = ((row + 1) & (SEQ - 1)) ? *(const u32x4*)(Gt + (size_t)(row + 1) * 2816 + ch) : z4;
                        uu[k] = *(const u32x4*)(U + (size_t)row * 2816 + ch);
                    }
                    float rn[4];
#pragma unroll
                    for (int k = 0; k < 4; ++k) rn[k] = rsl[rr + k + 2];
#pragma unroll
                    for (int k = 0; k < 4; ++k) {
                        const int row = r0 + rr + k;
                        const unsigned gpw[4] = {gp.x, gp.y, gp.z, gp.w}, gcw[4] = {gc.x, gc.y, gc.z, gc.w}, gnw[4] = {gn[k].x, gn[k].y, gn[k].z, gn[k].w}, uw[4] = {uu[k].x, uu[k].y, uu[k].z, uu[k].w};
                        unsigned ow[4];
#pragma unroll
                        for (int d = 0; d < 4; ++d) {
                            const int hh = d >> 1, e0 = (d & 1) * 2;
                            const float a0 = bflo(gpw[d]) * rp * w0[hh][e0] + bflo(gcw[d]) * rc * w1[hh][e0] + bflo(gnw[d]) * rn[k] * w2[hh][e0] + cb[hh][e0];
                            const float a1 = bfhi(gpw[d]) * rp * w0[hh][e0 + 1] + bfhi(gcw[d]) * rc * w1[hh][e0 + 1] + bfhi(gnw[d]) * rn[k] * w2[hh][e0 + 1] + cb[hh][e0 + 1];
                            ow[d] = cvt_pk_bf16(a0 * sigmoidf_(a0) * (bflo(uw[d]) * rc), a1 * sigmoidf_(a1) * (bfhi(uw[d]) * rc));
                        }
                        *(u32x4*)(U + (size_t)row * 2816 + ch) = (u32x4){ow[0], ow[1], ow[2], ow[3]};
                        gp = gc; gc = gn[k]; rp = rc; rc = rn[k];
                    }
                }
            }
        }
    }
    GRID_SYNC();
    {
        pg8::StaticOrder S; S.init(T, 1024, G, c);
        EpiRes<1> E; E.base = ws + O_HB2; E.HB = (bf16_t*)(ws + O_HB3); E.ssp = (float*)(ws + O_SSP4);
        pg8::gemm_phase(lds, pg8::Gemm{(const bf16_t*)(ws + O_U), (const bf16_t*)(ws + O_WDN), T, 1024, 2816, 2816, 2816}, S, E);
    }
    GRID_SYNC();
    if (STOP_AFTER == 10) return;
    {
        const bf16_t* HB3 = (const bf16_t*)(ws + O_HB3); const float* ssp = (const float*)(ws + O_SSP4);
        int tid_ = threadIdx.x; asm volatile("" : "+v"(tid_));
        const int lane = tid_ & 63, w = tid_ >> 6;
        for (int r = (c * 8 + w) * 2; r < T; r += G * 16) {
            u32x4 hv[2][2]; float rs[2];
#pragma unroll
            for (int k = 0; k < 2; ++k) {
#pragma unroll
                for (int i = 0; i < 2; ++i) hv[k][i] = *(const u32x4*)(HB3 + (size_t)(r + k) * 1024 + (i * 64 + lane) * 8);
                const f32x4* q = (const f32x4*)(ssp + (size_t)(r + k) * 16); const f32x4 t = (q[0] + q[1]) + (q[2] + q[3]);
                rs[k] = rsqrtf(((t[0] + t[1]) + (t[2] + t[3])) * (1.0f / 1024.0f) + 1e-6f);
            }
#pragma unroll
            for (int k = 0; k < 2; ++k)
#pragma unroll
                for (int i = 0; i < 2; ++i) {
                    const int col = (i * 64 + lane) * 8;
                    const f32x4 g0 = *(const f32x4*)(p.final_norm + col), g1 = *(const f32x4*)(p.final_norm + col + 4);
                    const u32x4 v = hv[k][i];
                    f32x4 o0, o1;
                    o0[0] = bflo(v.x) * rs[k] * g0[0]; o0[1] = bfhi(v.x) * rs[k] * g0[1]; o0[2] = bflo(v.y) * rs[k] * g0[2]; o0[3] = bfhi(v.y) * rs[k] * g0[3];
                    o1[0] = bflo(v.z) * rs[k] * g1[0]; o1[1] = bfhi(v.z) * rs[k] * g1[1]; o1[2] = bflo(v.w) * rs[k] * g1[2]; o1[3] = bfhi(v.w) * rs[k] * g1[3];
                    *(f32x4*)(p.out + (size_t)(r + k) * 1024 + col) = o0; *(f32x4*)(p.out + (size_t)(r + k) * 1024 + col + 4) = o1;
                }
        }
    }
}

extern "C" void kernel_launch(void* const* d_in, const int* in_sizes, int n_in, void* d_out, int out_size, void* d_ws, size_t ws_size,
                              hipStream_t stream) {
    constexpr size_t kDynLds = 143360;
    static int grid_blocks = 0;
    if (!grid_blocks) {
        int dev = 0, cus = 0, per_cu = 0;
        hipGetDevice(&dev);
        hipDeviceGetAttribute(&cus, hipDeviceAttributeMultiprocessorCount, dev);
        hipFuncSetAttribute((const void*)mk_kernel, hipFuncAttributeMaxDynamicSharedMemorySize, (int)kDynLds);
        hipOccupancyMaxActiveBlocksPerMultiprocessor(&per_cu, mk_kernel, 512, kDynLds);
        if (per_cu < 1) per_cu = 1;
        grid_blocks = cus * per_cu;
        if (grid_blocks > 256) grid_blocks = 256;
    }
    Params p; memset(&p, 0, sizeof(p));
    p.x = (const float*)d_in[0]; p.mem = (const float*)d_in[1]; p.positions = (const int*)d_in[2];
    const float* norm_mix = (const float*)d_in[3]; const float* w_in = (const float*)d_in[4];
    p.lower_bounds = (const float*)d_in[5]; p.hg_norm = (const float*)d_in[6]; p.sink = (const float*)d_in[7];
    const float* w_br_rec = (const float*)d_in[8]; const float* w_br_att = (const float*)d_in[9]; const float* w_mix_out = (const float*)d_in[10];
    const float* norm_mem = (const float*)d_in[11]; const float* norm_mem_kv = (const float*)d_in[12];
    const float* w_mem_q = (const float*)d_in[13]; const float* w_mem_kv = (const float*)d_in[14]; const float* w_mem_o = (const float*)d_in[15];
    const float* norm_ffn = (const float*)d_in[16]; const float* w_up = (const float*)d_in[17];
    p.conv_w = (const float*)d_in[18]; p.conv_b = (const float*)d_in[19];
    const float* w_down = (const float*)d_in[20]; p.final_norm = (const float*)d_in[21];
    p.out = (float*)d_out; p.ws = (unsigned char*)d_ws;
    for (int i = 0; i < 8; ++i) p.inv_freq[i] = std::pow(500000.0, -(double)i / 8.0);
    int t0 = 0;
    auto job = [&](int idx, const float* src, const float* gain, size_t off, int K, int N, int ldo, int koff, float scale) {
        TJob& j = p.jobs[idx]; j.src = src; j.gain = gain; j.dst_off = (unsigned long long)off; j.K = K; j.N = N; j.ldo = ldo; j.koff = koff; j.scale = scale; j.tile0 = t0;
        t0 += (K / 64) * (N / 256);
    };
    job(0, w_in, norm_mix, O_WIN, 1024, 5376, 1024, 0, 1.0f);
    job(1, w_mem_kv, norm_mem_kv, O_WMKV, 1024, 2048, 1024, 0, 1.0f);
    job(2, w_up, norm_ffn, O_WUP, 1024, 5632, 1024, 0, 1.0f);
    job(3, w_down, nullptr, O_WDN, 2816, 1024, 2816, 0, 1.0f);
    job(4, w_br_rec, nullptr, O_WMID, 512, 1024, 1024, 0, 1.0f);
    job(5, w_br_att, nullptr, O_WMID, 512, 1024, 1024, 512, 1.0f);
    job(6, w_mix_out, nullptr, O_WOUT, 1024, 1024, 1024, 0, 1.0f);
    job(7, w_mem_q, norm_mem, O_WMQ, 1024, 1024, 1024, 0, 0.0625f);
    job(8, w_mem_o, nullptr, O_WMO, 1024, 1024, 1024, 0, 1.0f);
    p.njobs = 9; p.ntiles = t0;
    hipMemsetAsync((unsigned char*)d_ws + O_BAR, 0, XCD_BAR_WORDS * 4, stream);
    void* args[] = {&p};
    hipError_t e = hipLaunchCooperativeKernel((const void*)mk_kernel, dim3(grid_blocks), dim3(512), args, kDynLds, stream);
    if (e != hipSuccess) fprintf(stderr, "cooperative launch failed: %s (grid %d)\n", hipGetErrorString(e), grid_blocks);
}
```

```cpp
#include <hip/hip_runtime.h>
#include <hip/hip_cooperative_groups.h>
#include <cstdio>
#include <cstring>
#include <cmath>
namespace cg = cooperative_groups;

#define LAS __attribute__((address_space(3)))
typedef unsigned short bf16_t;
typedef short bf16x8 __attribute__((ext_vector_type(8)));
typedef short s16x4 __attribute__((ext_vector_type(4)));
typedef float f32x4 __attribute__((ext_vector_type(4)));
typedef float f32x2 __attribute__((ext_vector_type(2)));
typedef unsigned u32x4 __attribute__((ext_vector_type(4)));
typedef unsigned u32x2 __attribute__((ext_vector_type(2)));
typedef _Float16 h16x4 __attribute__((ext_vector_type(4)));
typedef _Float16 h16x8 __attribute__((ext_vector_type(8)));

constexpr int T = 32768, SEQ = 4096;
constexpr size_t MiB = 1u << 20;
constexpr size_t O_WIN = 0;
constexpr size_t O_WMID = O_WIN + 5376ull * 1024 * 2;
constexpr size_t O_WOUT = O_WMID + 2 * MiB;
constexpr size_t O_WMQ = O_WOUT + 2 * MiB;
constexpr size_t O_WMKV = O_WMQ + 2 * MiB;
constexpr size_t O_WMO = O_WMKV + 4 * MiB;
constexpr size_t O_WUP = O_WMO + 2 * MiB;
constexpr size_t O_WDN = O_WUP + 11 * MiB;
constexpr size_t O_RSTD1 = 40 * MiB;
constexpr size_t O_SS2 = O_RSTD1 + 131072;
constexpr size_t O_SS3 = O_SS2 + 131072;
constexpr size_t O_SS4 = O_SS3 + 131072;
constexpr size_t O_RSTDM = O_SS4 + 131072;
constexpr size_t O_LBT = O_RSTDM + 8192;
constexpr size_t O_BAR = 40 * MiB + 768 * 1024;
constexpr size_t O_CS = 41 * MiB;
constexpr size_t O_KVM = 43 * MiB;
constexpr size_t O_MEMB = 51 * MiB;
constexpr size_t O_XB = 56 * MiB;
constexpr size_t O_OF = 56 * MiB, O_OB = 88 * MiB;
constexpr size_t O_QH = 120 * MiB, O_KKF = 152 * MiB, O_KKB = 184 * MiB, O_VH = 216 * MiB, O_SG = 248 * MiB;
constexpr size_t O_QA = 280 * MiB, O_KA = 312 * MiB, O_VA = 320 * MiB;
constexpr size_t O_OA = 328 * MiB;
constexpr size_t O_MERGED = 392 * MiB;
constexpr size_t O_QB = 392 * MiB, O_SMID = 424 * MiB;
constexpr size_t O_HB1 = 120 * MiB, O_QM = 184 * MiB, O_OM = 248 * MiB, O_HB2 = 56 * MiB;
constexpr size_t O_U = 120 * MiB, O_G = 296 * MiB;
constexpr size_t O_SSP2 = 472 * MiB, O_SSP3 = 474 * MiB, O_SSP4 = 476 * MiB;
constexpr size_t O_HB3 = 296 * MiB;

__device__ __forceinline__ float bf2f(unsigned short b) { return __uint_as_float(((unsigned)b) << 16); }
__device__ __forceinline__ float bflo(unsigned w) { return __uint_as_float(w << 16); }
__device__ __forceinline__ float bfhi(unsigned w) { return __uint_as_float(w & 0xffff0000u); }
typedef __bf16 bf16x2_t __attribute__((ext_vector_type(2)));
__device__ __forceinline__ unsigned cvt_pk_bf16(float lo, float hi) { const f32x2 v = {lo, hi}; return __builtin_bit_cast(unsigned, __builtin_convertvector(v, bf16x2_t)); }
__device__ __forceinline__ float sigmoidf_(float x) { return __builtin_amdgcn_rcpf(1.0f + __expf(-x)); }
__device__ __forceinline__ u32x2 pack4(f32x4 v) { u32x2 w; w.x = cvt_pk_bf16(v[0], v[1]); w.y = cvt_pk_bf16(v[2], v[3]); return w; }

struct TJob { const float* src; const float* gain; unsigned long long dst_off; int K, N, ldo, koff; float scale; int tile0; };

struct Params {
    const float* x; const float* mem; const int* positions; const float* lower_bounds; const float* hg_norm; const float* sink;
    const float* conv_w; const float* conv_b; const float* final_norm;
    float* out; unsigned char* ws;
    double inv_freq[8];
    TJob jobs[9];
    int njobs; int ntiles;
};

namespace pg8 {
constexpr int BM = 256, BK = 64, HALF = 128, HTB = HALF * BK * 2, STAGE_BYTES = 8 * HTB, NXCD = 8, WGM = 8;
__host__ __device__ __forceinline__ int lds_byte(int r, int c) { const int st = (r >> 4) * 2 + (c >> 5), rr = r & 15, cc = c & 31, ob = rr * 64 + cc * 2; return st * 1024 + (ob ^ (((ob >> 9) & 1) << 5)); }
__host__ __device__ __forceinline__ void stage_rc(int b, int& R, int& C) { const int st = b / 1024, sb = b % 1024, swz = sb ^ (((sb >> 9) & 1) << 5); R = (st >> 1) * 16 + swz / 64; C = (st & 1) * 32 + (swz % 64) / 2; }
__host__ __device__ __forceinline__ int perm32(int rho) { const int n = rho >> 4, i = rho & 15; return 8 * (i >> 2) + 4 * n + (i & 3); }
struct Unit { int pm, pn; };
struct Gemm { const bf16_t* A; const bf16_t* Bt; int M, N, K, lda, ldb; };
struct StaticOrder {
    int nM, nN, nwg, G, c;
    __host__ __device__ void init(int M, int N, int G_, int c_) { nM = M / BM; nN = N / BM; nwg = nM * nN; G = G_; c = c_; }
    __host__ __device__ bool next(int i, Unit& u) const {
        const long L = (long)i * G + c; if (L >= nwg) return false;
        int wgid = (int)L; { const int q = nwg / NXCD, r = nwg % NXCD, xcd = wgid % NXCD, off = wgid / NXCD; wgid = (xcd < r ? xcd * (q + 1) : r * (q + 1) + (xcd - r) * q) + off; }
        const int nig = WGM * nN, gid = wgid / nig, fm = gid * WGM, gsz = (nM - fm) < WGM ? (nM - fm) : WGM;
        u.pm = fm + ((wgid % nig) % gsz); u.pn = (wgid % nig) / gsz; return true;
    }
    __device__ __forceinline__ void a_ready(const Unit&) const {}
    __device__ __forceinline__ void done(const Unit&) const {}
};

template <class Epi, class Sched>
__device__ __forceinline__ void gemm_phase(LAS unsigned char* lds, const Gemm g, const Sched& S, const Epi& E) {
    int tid = threadIdx.x; asm volatile("" : "+v"(tid));
    const int wid = __builtin_amdgcn_readfirstlane(tid >> 6), lane = tid & 63, wr = wid >> 2, wc = wid & 3, fr = lane & 15, fq = lane >> 4;
    const int K = g.K, nt = K / BK;
    unsigned voffA[2], voffB[2];
#pragma unroll
    for (int i = 0; i < 2; ++i) { int R, C; stage_rc(tid * 16 + i * 8192, R, C); const int Rb = Epi::PERM ? ((R & ~31) + perm32(R & 31)) : R;
        voffA[i] = (unsigned)(R * g.lda + C) * 2u; voffB[i] = (unsigned)(Rb * g.ldb + C) * 2u; }
    const size_t kstep = (size_t)(BK * 2);
    const size_t hstepA = (size_t)HALF * g.lda * 2, hstepB = (size_t)HALF * g.ldb * 2;
    const size_t tstepA = 2 * hstepA, tstepB = 2 * hstepB;
    const unsigned ldsw = (unsigned)wid * 1024u;
    const int aoff = lds_byte(wr * 64 + fr, fq * 8), boff = lds_byte(wc * 32 + fr, fq * 8);
#define PG8_SA(b, h) (((b) * 2 + (h)) * HTB)
#define PG8_SB(b, h) ((4 + (b) * 2 + (h)) * HTB)
#define PG8_STAGE(bufoff, gbase, voff) do { _Pragma("unroll") for (int _i = 0; _i < 2; ++_i) \
        __builtin_amdgcn_global_load_lds((const unsigned*)((const char*)(gbase) + (voff)[_i]), (LAS unsigned*)(lds + (bufoff) + ldsw + _i * 8192), 16, 0, 0); } while (0)
#define PG8_LDA(dst, b, h) do { _Pragma("unroll") for (int m = 0; m < 4; ++m) _Pragma("unroll") for (int k = 0; k < 2; ++k) dst[m][k] = *(const LAS bf16x8*)(lds + PG8_SA(b, h) + aoff + m * 2048 + k * 1024); } while (0)
#define PG8_LDB(dst, b, h) do { _Pragma("unroll") for (int n = 0; n < 2; ++n) _Pragma("unroll") for (int k = 0; k < 2; ++k) dst[n][k] = *(const LAS bf16x8*)(lds + PG8_SB(b, h) + boff + n * 2048 + k * 1024); } while (0)
#define PG8_MMA(ai, bj, At, Bt) do { __builtin_amdgcn_s_setprio(1); _Pragma("unroll") for (int m = 0; m < 4; ++m) _Pragma("unroll") for (int n = 0; n < 2; ++n) _Pragma("unroll") for (int k = 0; k < 2; ++k) \
        acc[ai][bj][m][n] = __builtin_amdgcn_mfma_f32_16x16x32_bf16(Bt[n][k], At[m][k], acc[ai][bj][m][n], 0, 0, 0); __builtin_amdgcn_s_setprio(0); } while (0)
#define PG8_WAIT_V(n) asm volatile("s_waitcnt vmcnt(" #n ")" ::: "memory")
#define PG8_WAIT_L(n) asm volatile("s_waitcnt lgkmcnt(" #n ")" ::: "memory")
#define PG8_BAR __builtin_amdgcn_s_barrier()
#define PG8_SCHED __builtin_amdgcn_sched_barrier(0)
    Unit cur, nxt; int ui = 0;
    if (!S.next(0, cur)) return;
    f32x4 acc[2][2][4][2];
#pragma unroll
    for (int a = 0; a < 2; ++a)
#pragma unroll
        for (int b = 0; b < 2; ++b)
#pragma unroll
            for (int m = 0; m < 4; ++m)
#pragma unroll
                for (int n = 0; n < 2; ++n) acc[a][b][m][n] = (f32x4){0.f, 0.f, 0.f, 0.f};
    bf16x8 At[4][2], B0[2][2], B1[2][2];
    const char* cA = (const char*)g.A + (size_t)cur.pm * tstepA; const char* cB = (const char*)g.Bt + (size_t)cur.pn * tstepB;
    S.a_ready(cur);
    PG8_STAGE(PG8_SB(0, 0), cB, voffB); PG8_STAGE(PG8_SA(0, 0), cA, voffA); PG8_STAGE(PG8_SB(0, 1), cB + hstepB, voffB); PG8_STAGE(PG8_SA(0, 1), cA + hstepA, voffA);
    if (wr == 1) PG8_BAR;
    PG8_WAIT_V(4); PG8_BAR;
    PG8_STAGE(PG8_SB(1, 0), cB + kstep, voffB); PG8_STAGE(PG8_SA(1, 0), cA + kstep, voffA); PG8_STAGE(PG8_SB(1, 1), cB + hstepB + kstep, voffB);
    PG8_WAIT_V(6); PG8_BAR;
    for (;;) {
        const bool has_next = S.next(ui + 1, nxt);
        const char* nA = has_next ? (const char*)g.A + (size_t)nxt.pm * tstepA : cA; const char* nB = has_next ? (const char*)g.Bt + (size_t)nxt.pn * tstepB : cB;
        for (int t = 0; t < nt; t += 2) {
            const bool last = (t == nt - 2);
            if constexpr (Epi::HAS_MID) { if (t == nt / 2) E.mid(acc, cur, wr, wc, fr, fq); }
            const char* a1 = cA + (size_t)(t + 1) * kstep;
            const char* a2 = last ? nA : cA + (size_t)(t + 2) * kstep; const char* b2 = last ? nB : cB + (size_t)(t + 2) * kstep;
            const char* a3 = a2 + kstep; const char* b3 = b2 + kstep;
            if (last && has_next) S.a_ready(nxt);
            PG8_LDB(B0, 0, 0); PG8_SCHED; PG8_LDA(At, 0, 0); PG8_STAGE(PG8_SA(1, 1), a1 + hstepA, voffA);
            PG8_WAIT_L(8); PG8_BAR; PG8_WAIT_L(0); PG8_MMA(0, 0, At, B0); PG8_BAR; PG8_SCHED;
            PG8_LDB(B1, 0, 1); PG8_STAGE(PG8_SB(0, 0), b2, voffB);
            PG8_BAR; PG8_WAIT_L(0); PG8_MMA(0, 1, At, B1); PG8_BAR;
            PG8_LDA(At, 0, 1); PG8_STAGE(PG8_SA(0, 0), a2, voffA);
            PG8_BAR; PG8_WAIT_L(0); PG8_MMA(1, 0, At, B0); PG8_BAR; PG8_SCHED;
            PG8_STAGE(PG8_SB(0, 1), b2 + hstepB, voffB);
            PG8_WAIT_V(6); PG8_BAR; PG8_MMA(1, 1, At, B1); PG8_BAR;
            PG8_LDB(B0, 1, 0); PG8_SCHED; PG8_LDA(At, 1, 0); PG8_STAGE(PG8_SA(0, 1), a2 + hstepA, voffA);
            PG8_WAIT_L(8); PG8_BAR; PG8_WAIT_L(0); PG8_MMA(0, 0, At, B0); PG8_BAR; PG8_SCHED;
            PG8_LDB(B1, 1, 1); PG8_STAGE(PG8_SB(1, 0), b3, voffB);
            PG8_BAR; PG8_WAIT_L(0); PG8_MMA(0, 1, At, B1); PG8_BAR;
            PG8_LDA(At, 1, 1); PG8_STAGE(PG8_SA(1, 0), a3, voffA);
            PG8_BAR; PG8_WAIT_L(0); PG8_MMA(1, 0, At, B0); PG8_BAR; PG8_SCHED;
            PG8_STAGE(PG8_SB(1, 1), b3 + hstepB, voffB);
            PG8_WAIT_V(6); PG8_BAR; PG8_MMA(1, 1, At, B1); PG8_BAR;
        }
        E(acc, cur, wr, wc, fr, fq); S.done(cur);
        if (!has_next) break;
#pragma unroll
        for (int a = 0; a < 2; ++a)
#pragma unroll
            for (int b = 0; b < 2; ++b)
#pragma unroll
                for (int m = 0; m < 4; ++m)
#pragma unroll
                    for (int n = 0; n < 2; ++n) acc[a][b][m][n] = (f32x4){0.f, 0.f, 0.f, 0.f};
        cur = nxt; cA = nA; cB = nB; ++ui;
    }
    PG8_WAIT_V(0);
    if (wr == 0) PG8_BAR;
    PG8_BAR;
#undef PG8_SA
#undef PG8_SB
#undef PG8_STAGE
#undef PG8_LDA
#undef PG8_LDB
#undef PG8_MMA
#undef PG8_WAIT_V
#undef PG8_WAIT_L
#undef PG8_BAR
#undef PG8_SCHED
}
}

#define EPI_LOOP_ROWS _Pragma("unroll") for (int ai = 0; ai < 2; ++ai) _Pragma("unroll") for (int m = 0; m < 4; ++m)
#define EPI_LOOP_COLS _Pragma("unroll") for (int bj = 0; bj < 2; ++bj) _Pragma("unroll") for (int n = 0; n < 2; ++n)

struct EpiProj {
    static constexpr bool PERM = true, HAS_MID = false;
    const float* rstd; const float* lbt; const float* cs;
    bf16_t *QH, *VH, *SG, *QA, *KA, *VA, *GR, *GA; _Float16 *KKF, *KKB;
    template <int MODE>
    __device__ __forceinline__ void run(const f32x4 (&acc)[2][2][4][2], const pg8::Unit& u, int wr, int wc, int fr, int fq) const {
        const int pn = u.pn;
        EPI_LOOP_ROWS {
            const int row = u.pm * 256 + ai * 128 + wr * 64 + m * 16 + fr;
#pragma unroll
            for (int bj = 0; bj < 2; ++bj) {
                const int col = pn * 256 + bj * 128 + wc * 32 + 8 * fq;
                f32x4 v0 = acc[ai][bj][m][0], v1 = acc[ai][bj][m][1];
                if (MODE == 0) {
#pragma unroll
                    for (int i = 0; i < 4; ++i) { v0[i] = v0[i] * sigmoidf_(v0[i]) * 0.08838834764831845f; v1[i] = v1[i] * sigmoidf_(v1[i]) * 0.08838834764831845f; }
                    const u32x2 lo = pack4(v0), hi = pack4(v1);
                    *(u32x4*)(QH + (size_t)row * 512 + col) = (u32x4){lo.x, lo.y, hi.x, hi.y};
                } else if (MODE == 1 || MODE == 2) {
                    const int c = col - (MODE == 1 ? 512 : 1024);
                    const f32x4 lb0 = *(const f32x4*)(lbt + (MODE == 1 ? 0 : 512) + c), lb1 = *(const f32x4*)(lbt + (MODE == 1 ? 0 : 512) + c + 4);
                    h16x8 o;
#pragma unroll
                    for (int i = 0; i < 4; ++i) {
                        o[i] = (_Float16)__log2f(1.0f - (1.0f - lb0[i]) * __builtin_amdgcn_rcpf(1.0f + __expf(v0[i])));
                        o[4 + i] = (_Float16)__log2f(1.0f - (1.0f - lb1[i]) * __builtin_amdgcn_rcpf(1.0f + __expf(v1[i])));
                    }
                    *(h16x8*)((MODE == 1 ? KKF : KKB) + (size_t)row * 512 + c) = o;
                } else if (MODE == 3) {
                    const u32x2 lo = pack4(v0), hi = pack4(v1);
                    *(u32x4*)(VH + (size_t)row * 512 + (col - 1536)) = (u32x4){lo.x, lo.y, hi.x, hi.y};
                } else if (MODE == 4) {
#pragma unroll
                    for (int i = 0; i < 4; ++i) { v0[i] = v0[i] * sigmoidf_(v0[i]); v1[i] = v1[i] * sigmoidf_(v1[i]); }
                    const u32x2 lo = pack4(v0), hi = pack4(v1);
                    *(u32x4*)(SG + (size_t)row * 512 + (col - 2048)) = (u32x4){lo.x, lo.y, hi.x, hi.y};
                } else if (MODE == 5 || MODE == 6) {
                    const bool rot = ((wc & 1) == 0) && (MODE == 5 || bj == 0);
                    if (rot) {
                        f32x4 p0, p1;
#pragma unroll
                        for (int i = 0; i < 4; ++i) { p0[i] = __shfl_xor(v0[i], 16); p1[i] = __shfl_xor(v1[i], 16); }
                        const f32x4 c0 = *(const f32x4*)(cs + (size_t)row * 16), c1 = *(const f32x4*)(cs + (size_t)row * 16 + 4);
                        const f32x4 s0 = *(const f32x4*)(cs + (size_t)row * 16 + 8), s1 = *(const f32x4*)(cs + (size_t)row * 16 + 12);
                        const f32x4 r0a = v0 * c0 - p0 * s0, r1a = v1 * c1 - p1 * s1, r0b = v0 * c0 + p0 * s0, r1b = v1 * c1 + p1 * s1;
                        v0 = (fq == 0) ? r0a : ((fq == 1) ? r0b : v0); v1 = (fq == 0) ? r1a : ((fq == 1) ? r1b : v1);
                    }
                    if (MODE == 5) { v0 = v0 * 0.125f; v1 = v1 * 0.125f; }
                    const u32x2 lo = pack4(v0), hi = pack4(v1); const u32x4 w = (u32x4){lo.x, lo.y, hi.x, hi.y};
                    if (MODE == 5) *(u32x4*)(QA + (size_t)row * 512 + (col - 2560)) = w;
                    else if (bj == 0) *(u32x4*)(KA + (size_t)row * 128 + (col - 3072)) = w;
                    else *(u32x4*)(VA + (size_t)row * 128 + (col - 3200)) = w;
                } else {
#pragma unroll
                    for (int i = 0; i < 4; ++i) { v0[i] = sigmoidf_(v0[i]); v1[i] = sigmoidf_(v1[i]); }
                    const u32x2 lo = pack4(v0), hi = pack4(v1); const u32x4 w = (u32x4){lo.x, lo.y, hi.x, hi.y};
                    if (MODE == 7) *(u32x4*)(GR + (size_t)row * 1024 + (col - 3328)) = w;
                    else *(u32x4*)(GA + (size_t)row * 1024 + (col - 4352)) = w;
                }
            }
        }
    }
    __device__ __forceinline__ void operator()(const f32x4 (&acc)[2][2][4][2], const pg8::Unit& u, int wr, int wc, int fr, int fq) const {
        const int pn = u.pn;
        if (pn < 2) run<0>(acc, u, wr, wc, fr, fq);
        else if (pn < 4) run<1>(acc, u, wr, wc, fr, fq);
        else if (pn < 6) run<2>(acc, u, wr, wc, fr, fq);
        else if (pn < 8) run<3>(acc, u, wr, wc, fr, fq);
        else if (pn < 10) run<4>(acc, u, wr, wc, fr, fq);
        else if (pn < 12) run<5>(acc, u, wr, wc, fr, fq);
        else if (pn == 12) run<6>(acc, u, wr, wc, fr, fq);
        else if (pn < 17) run<7>(acc, u, wr, wc, fr, fq);
        else run<8>(acc, u, wr, wc, fr, fq);
    }
};

__device__ __forceinline__ void epi_membar() { asm volatile("" ::: "memory"); }
template <int MODE>
struct EpiScale {
    static constexpr bool PERM = (MODE != 0), HAS_MID = false;
    const float* rs; bf16_t* O; int ldo; bf16_t* O2; int split;
    __device__ __forceinline__ void operator()(const f32x4 (&acc)[2][2][4][2], const pg8::Unit& u, int wr, int wc, int fr, int fq) const {
        bf16_t* base = O; int cb = u.pn * 256;
        if (cb >= split) { base = O2; cb -= split; }
        EPI_LOOP_ROWS {
            const int row = u.pm * 256 + ai * 128 + wr * 64 + m * 16 + fr;
            float s;
            if (MODE == 0) s = rs[row];
            else if (MODE == 2) s = 1.0f;
            else { const f32x4* q = (const f32x4*)(rs + (size_t)row * 16); const f32x4 t = (q[0] + q[1]) + (q[2] + q[3]); s = rsqrtf(((t[0] + t[1]) + (t[2] + t[3])) * (1.0f / 1024.0f) + 1e-6f); }
            if constexpr (PERM) {
#pragma unroll
                for (int bj = 0; bj < 2; ++bj) {
                    const int col = cb + bj * 128 + wc * 32 + 8 * fq;
                    const u32x2 lo = pack4(acc[ai][bj][m][0] * s), hi = pack4(acc[ai][bj][m][1] * s);
                    *(u32x4*)(base + (size_t)row * ldo + col) = (u32x4){lo.x, lo.y, hi.x, hi.y};
                }
                epi_membar();
            } else {
                EPI_LOOP_COLS {
                    const int col = cb + bj * 128 + wc * 32 + n * 16 + 4 * fq;
                    *(u32x2*)(base + (size_t)row * ldo + col) = pack4(acc[ai][bj][m][n] * s);
                }
            }
        }
    }
};

struct EpiMergeFused {
    static constexpr bool PERM = true, HAS_MID = true;
    const bf16_t* GR; const bf16_t* GA; bf16_t* O;
    __device__ __forceinline__ void mid(f32x4 (&acc)[2][2][4][2], const pg8::Unit& u, int wr, int wc, int fr, int fq) const {
        asm volatile("" : "+v"(fr), "+v"(fq));
#pragma unroll
        for (int ai = 0; ai < 2; ++ai)
#pragma unroll
            for (int m = 0; m < 4; ++m) {
                const int row = u.pm * 256 + ai * 128 + wr * 64 + m * 16 + fr;
#pragma unroll
                for (int bj = 0; bj < 2; ++bj) {
                    const int col = u.pn * 256 + bj * 128 + wc * 32 + 8 * fq;
                    const u32x4 r = *(const u32x4*)(GR + (size_t)row * 1024 + col), a = *(const u32x4*)(GA + (size_t)row * 1024 + col);
                    f32x4 f0, f1;
                    f0[0] = bflo(r.x) * __builtin_amdgcn_rcpf(fmaxf(bflo(a.x), 1e-30f)); f0[1] = bfhi(r.x) * __builtin_amdgcn_rcpf(fmaxf(bfhi(a.x), 1e-30f));
                    f0[2] = bflo(r.y) * __builtin_amdgcn_rcpf(fmaxf(bflo(a.y), 1e-30f)); f0[3] = bfhi(r.y) * __builtin_amdgcn_rcpf(fmaxf(bfhi(a.y), 1e-30f));
                    f1[0] = bflo(r.z) * __builtin_amdgcn_rcpf(fmaxf(bflo(a.z), 1e-30f)); f1[1] = bfhi(r.z) * __builtin_amdgcn_rcpf(fmaxf(bfhi(a.z), 1e-30f));
                    f1[2] = bflo(r.w) * __builtin_amdgcn_rcpf(fmaxf(bflo(a.w), 1e-30f)); f1[3] = bfhi(r.w) * __builtin_amdgcn_rcpf(fmaxf(bfhi(a.w), 1e-30f));
                    acc[ai][bj][m][0] = acc[ai][bj][m][0] * f0; acc[ai][bj][m][1] = acc[ai][bj][m][1] * f1;
                }
                if (m == 3) epi_membar();
            }
    }
    __device__ __forceinline__ void operator()(const f32x4 (&acc)[2][2][4][2], const pg8::Unit& u, int wr, int wc, int fr, int fq) const {
        EPI_LOOP_ROWS {
            const int row = u.pm * 256 + ai * 128 + wr * 64 + m * 16 + fr;
#pragma unroll
            for (int bj = 0; bj < 2; ++bj) {
                const int col = u.pn * 256 + bj * 128 + wc * 32 + 8 * fq;
                const u32x4 a = *(const u32x4*)(GA + (size_t)row * 1024 + col);
                f32x4 f0, f1; f0[0] = bflo(a.x); f0[1] = bfhi(a.x); f0[2] = bflo(a.y); f0[3] = bfhi(a.y); f1[0] = bflo(a.z); f1[1] = bfhi(a.z); f1[2] = bflo(a.w); f1[3] = bfhi(a.w);
                const u32x2 lo = pack4(acc[ai][bj][m][0] * f0), hi = pack4(acc[ai][bj][m][1] * f1);
                *(u32x4*)(O + (size_t)row * 1024 + col) = (u32x4){lo.x, lo.y, hi.x, hi.y};
            }
        }
    }
};

template <int BASE_BF16>
struct EpiRes {
    static constexpr bool PERM = true, HAS_MID = false;
    const void* base; bf16_t* HB; float* ssp;
    __device__ __forceinline__ void operator()(const f32x4 (&acc)[2][2][4][2], const pg8::Unit& u, int wr, int wc, int fr, int fq) const {
        EPI_LOOP_ROWS {
            const int row = u.pm * 256 + ai * 128 + wr * 64 + m * 16 + fr;
            float sq = 0.f;
#pragma unroll
            for (int bj = 0; bj < 2; ++bj) {
                const int col = u.pn * 256 + bj * 128 + wc * 32 + 8 * fq;
                f32x4 h0, h1;
                if (BASE_BF16) { const u32x4 b = *(const u32x4*)((const bf16_t*)base + (size_t)row * 1024 + col);
                    h0[0] = bflo(b.x); h0[1] = bfhi(b.x); h0[2] = bflo(b.y); h0[3] = bfhi(b.y); h1[0] = bflo(b.z); h1[1] = bfhi(b.z); h1[2] = bflo(b.w); h1[3] = bfhi(b.w); }
                else { h0 = *(const f32x4*)((const float*)base + (size_t)row * 1024 + col); h1 = *(const f32x4*)((const float*)base + (size_t)row * 1024 + col + 4); }
                h0 = h0 + acc[ai][bj][m][0]; h1 = h1 + acc[ai][bj][m][1];
                const u32x2 lo = pack4(h0), hi = pack4(h1);
                *(u32x4*)(HB + (size_t)row * 1024 + col) = (u32x4){lo.x, lo.y, hi.x, hi.y};
                sq += (h0[0] * h0[0] + h0[1] * h0[1] + h0[2] * h0[2] + h0[3] * h0[3]) + (h1[0] * h1[0] + h1[1] * h1[1] + h1[2] * h1[2] + h1[3] * h1[3]);
            }
            sq += __shfl_xor(sq, 16); sq += __shfl_xor(sq, 32);
            if (fq == 0) ssp[(size_t)row * 16 + u.pn * 4 + wc] = sq;
        }
    }
};

__device__ __forceinline__ void rownorm_bf16_x2(const float* H, bf16_t* HB, int row, int lane) {
    const f32x4* s0 = (const f32x4*)(H + (size_t)row * 1024); const f32x4* s1 = s0 + 256;
    f32x4 v0[4], v1[4]; float a0 = 0.f, a1 = 0.f;
#pragma unroll
    for (int i = 0; i < 4; ++i) { v0[i] = s0[i * 64 + lane]; v1[i] = s1[i * 64 + lane]; }
#pragma unroll
    for (int i = 0; i < 4; ++i) { a0 += v0[i][0] * v0[i][0] + v0[i][1] * v0[i][1] + v0[i][2] * v0[i][2] + v0[i][3] * v0[i][3]; a1 += v1[i][0] * v1[i][0] + v1[i][1] * v1[i][1] + v1[i][2] * v1[i][2] + v1[i][3] * v1[i][3]; }
#pragma unroll
    for (int o = 32; o >= 1; o >>= 1) { a0 += __shfl_xor(a0, o); a1 += __shfl_xor(a1, o); }
    const float r0 = rsqrtf(a0 * (1.0f / 1024.0f) + 1e-6f), r1 = rsqrtf(a1 * (1.0f / 1024.0f) + 1e-6f);
#pragma unroll
    for (int i = 0; i < 4; ++i) { *(u32x2*)(HB + (size_t)row * 1024 + (i * 64 + lane) * 4) = pack4(v0[i] * r0); *(u32x2*)(HB + (size_t)(row + 1) * 1024 + (i * 64 + lane) * 4) = pack4(v1[i] * r1); }
}

__device__ __forceinline__ void transpose_tile(const TJob& j, bf16_t* dst, int tile, LAS float* tl) {
    const int tid = threadIdx.x;
    const int ntn = j.N / 256; const int tk = tile / ntn, tn = tile % ntn; const int k0 = tk * 64, n0 = tn * 256;
    {
        const int r = tid >> 6, c4 = (tid & 63) * 4;
        f32x4 v[8];
#pragma unroll
        for (int ps = 0; ps < 8; ++ps) v[ps] = __builtin_nontemporal_load((const f32x4*)(j.src + (size_t)(k0 + r + 8 * ps) * j.N + n0 + c4));
#pragma unroll
        for (int ps = 0; ps < 8; ++ps) {
            const float g = j.gain ? j.gain[k0 + r + 8 * ps] * j.scale : j.scale;
            LAS float* t = tl + (r + 8 * ps) * 257 + c4;
            t[0] = v[ps][0] * g; t[1] = v[ps][1] * g; t[2] = v[ps][2] * g; t[3] = v[ps][3] * g;
        }
    }
    __syncthreads();
    {
        const int n = tid >> 1, kh = (tid & 1) * 32;
#pragma unroll
        for (int q = 0; q < 4; ++q) {
            const int kc = kh + 8 * q;
            u32x4 w;
            w.x = cvt_pk_bf16(tl[(kc + 0) * 257 + n], tl[(kc + 1) * 257 + n]); w.y = cvt_pk_bf16(tl[(kc + 2) * 257 + n], tl[(kc + 3) * 257 + n]);
            w.z = cvt_pk_bf16(tl[(kc + 4) * 257 + n], tl[(kc + 5) * 257 + n]); w.w = cvt_pk_bf16(tl[(kc + 6) * 257 + n], tl[(kc + 7) * 257 + n]);
            *(u32x4*)(dst + (size_t)(n0 + n) * j.ldo + j.koff + k0 + kc) = w;
        }
    }
    __syncthreads();
}

__device__ __forceinline__ void rowprep2(const float* src, bf16_t* dst, float* rstd, int row, int lane) {
    const f32x4* s0 = (const f32x4*)(src + (size_t)row * 1024); const f32x4* s1 = s0 + 256;
    f32x4 v0[4], v1[4]; float a0 = 0.f, a1 = 0.f;
#pragma unroll
    for (int i = 0; i < 4; ++i) { v0[i] = __builtin_nontemporal_load(s0 + i * 64 + lane); v1[i] = __builtin_nontemporal_load(s1 + i * 64 + lane); }
#pragma unroll
    for (int i = 0; i < 4; ++i) {
        a0 += v0[i][0] * v0[i][0] + v0[i][1] * v0[i][1] + v0[i][2] * v0[i][2] + v0[i][3] * v0[i][3];
        a1 += v1[i][0] * v1[i][0] + v1[i][1] * v1[i][1] + v1[i][2] * v1[i][2] + v1[i][3] * v1[i][3];
    }
#pragma unroll
    for (int o = 32; o >= 1; o >>= 1) { a0 += __shfl_xor(a0, o); a1 += __shfl_xor(a1, o); }
    const float r0 = rsqrtf(a0 * (1.0f / 1024.0f) + 1e-6f), r1 = rsqrtf(a1 * (1.0f / 1024.0f) + 1e-6f);
#pragma unroll
    for (int i = 0; i < 4; ++i) { *(u32x2*)(dst + (size_t)row * 1024 + (i * 64 + lane) * 4) = pack4(v0[i] * r0); *(u32x2*)(dst + (size_t)(row + 1) * 1024 + (i * 64 + lane) * 4) = pack4(v1[i] * r1); }
}

__device__ __forceinline__ void phase_prep(const Params& p, LAS unsigned char* lds, const int tr_lo, const int tr_hi, const bool rest, const int bid, const int nb) {
    const int tid = threadIdx.x, lane = tid & 63, w = tid >> 6;
    unsigned char* ws = p.ws;
    const int n_tr = tr_hi - tr_lo, n_x = T / 16, n_m = 2048 / 16, n_z = 0, n_cs = T * 8 / 512, n_lb = 2;
    const int total = rest ? n_tr + n_x + n_m + n_z + n_cs + n_lb : n_tr;
    for (int it = bid; it < total; it += nb) {
        int i = it;
        if (i < n_tr) {
            i += tr_lo;
            int jb = 0;
#pragma unroll
            for (int q = 1; q < 9; ++q) if (i >= p.jobs[q].tile0) jb = q;
            transpose_tile(p.jobs[jb], (bf16_t*)(ws + p.jobs[jb].dst_off), i - p.jobs[jb].tile0, (LAS float*)lds);
            continue;
        }
        i -= n_tr;
        if (i < n_x) { rowprep2(p.x, (bf16_t*)(ws + O_XB), (float*)(ws + O_RSTD1), (i * 8 + w) * 2, lane); continue; }
        i -= n_x;
        if (i < n_m) { rowprep2(p.mem, (bf16_t*)(ws + O_MEMB), (float*)(ws + O_RSTDM), (i * 8 + w) * 2, lane); continue; }
        i -= n_m;
        if (i < n_z) { ((float*)(ws + O_SS2))[i * 512 + tid] = 0.f; continue; }
        i -= n_z;
        if (i < n_cs) {
            const int idx = i * 512 + tid, row = idx >> 3, fi = idx & 7;
            const double xr = (double)p.positions[row] * p.inv_freq[fi] * 0.15915494309189535;
            const float fr = (float)(xr - rint(xr));
            float* cs = (float*)(ws + O_CS);
            cs[(size_t)row * 16 + fi] = __builtin_amdgcn_cosf(fr); cs[(size_t)row * 16 + 8 + fi] = __builtin_amdgcn_sinf(fr);
            continue;
        }
        i -= n_cs;
        {
            const int idx = i * 512 + tid, d = idx >> 9, k = idx & 511;
            const float a0 = p.lower_bounds[d * 1024 + k], a1 = p.lower_bounds[d * 1024 + 512 + k];
            ((float*)(ws + O_LBT))[idx] = 1.0f / (1.0f + __expf(a1 - a0));
        }
    }
}

__device__ __forceinline__ s16x4 lds_tr(const LAS bf16_t* ptr) { return __builtin_amdgcn_ds_read_tr16_b64_v4i16((LAS s16x4*)ptr); }
__device__ __forceinline__ bf16x8 cat44(s16x4 a, s16x4 b) { bf16x8 r; r[0] = a[0]; r[1] = a[1]; r[2] = a[2]; r[3] = a[3]; r[4] = b[0]; r[5] = b[1]; r[6] = b[2]; r[7] = b[3]; return r; }

__device__ __forceinline__ void hgrn_item(const Params& p, int item, LAS unsigned char* lds) {
    const int tid = threadIdx.x, lane = tid & 63, w = tid >> 6, l15 = lane & 15, q4 = lane >> 4;
    const int sgi = item & 1, chain = item >> 1, dir = chain & 1, h = (chain >> 1) & 3, b = chain >> 3;
    unsigned char* ws = p.ws;
    bf16_t* QB = (bf16_t*)(ws + O_QB); float* SM = (float*)(ws + O_SMID);
    float btot = 0.f;
    const _Float16* LF = (const _Float16*)(ws + (dir ? O_KKB : O_KKF));
    const bf16_t* QH = (const bf16_t*)(ws + O_QH); const bf16_t* VH = (const bf16_t*)(ws + O_VH);
    bf16_t* O = (bf16_t*)(ws + (dir ? O_OB : O_OF));
    LAS bf16_t* Ps = (LAS bf16_t*)(lds + 106496);
    LAS float* seg = (LAS float*)(lds + 115712);
#define HG_QM(bf_) ((LAS bf16_t*)(lds + (bf_) * 53248))
#define HG_KM(bf_) ((LAS bf16_t*)(lds + (bf_) * 53248 + 17408))
#define HG_VS(bf_) ((LAS bf16_t*)(lds + (bf_) * 53248 + 34816))
#define HG_EMID(bf_) ((LAS float*)(lds + (bf_) * 53248 + 52224))
#define HG_E2(bf_) ((LAS float*)(lds + (bf_) * 53248 + 52224 + 512))
    const int kc = tid & 127, sg = tid >> 7;
    const size_t rb = (size_t)b * SEQ; const int hc = h * 128;
    f32x4 S[8];
#pragma unroll
    for (int i = 0; i < 8; ++i) S[i] = (f32x4){0.f, 0.f, 0.f, 0.f};
    _Float16 lfv[16]; bf16_t qv[16]; u32x4 rv[2];
    f32x4 oacc[4];
#define HG_ROW(g) (rb + (size_t)(dir ? (SEQ - 1 - (g)) : (g)))
    const long rstep = dir ? -512 : 512;
    const int c0 = 32 * sgi, c1 = c0 + 32;
#define HG_PREFETCH(ci) do { \
        { const size_t o_ = HG_ROW((ci) * 64 + sg * 16) * 512 + hc + kc; const _Float16* lp_ = LF + o_; const bf16_t* qp_ = QH + o_; \
          _Pragma("unroll") for (int j = 0; j < 16; ++j) { lfv[j] = lp_[j * rstep]; qv[j] = qp_[j * rstep]; } } \
        _Pragma("unroll") for (int e = 0; e < 2; ++e) { const int c_ = tid + 512 * e; const size_t r_ = HG_ROW((ci) * 64 + (c_ >> 4)); rv[e] = *(const u32x4*)(VH + r_ * 512 + hc + (c_ & 15) * 8); } } while (0)
#define HG_PREP_A() do { float run = 0.f; _Pragma("unroll") for (int j = 0; j < 16; ++j) run += (float)lfv[j]; seg[sg * 128 + kc] = run; } while (0)
#define HG_PREP_B(cidx, bf_) do { \
        LAS bf16_t* Qm_ = HG_QM(bf_); LAS bf16_t* Km_ = HG_KM(bf_); LAS bf16_t* Vs_ = HG_VS(bf_); \
        const float s0 = seg[kc], s1 = seg[128 + kc], s2 = seg[256 + kc], s3 = seg[384 + kc]; \
        const float bmid = s0 + s1, bend = bmid + s2 + s3; \
        const float pre = (sg > 0 ? s0 : 0.f) + (sg > 1 ? s1 : 0.f) + (sg > 2 ? s2 : 0.f) - bmid; \
        const float ek = sgi ? __builtin_amdgcn_exp2f(btot + bmid) : 0.f; \
        bf16_t* qbp = QB + HG_ROW((cidx) * 64 + sg * 16) * 512 + hc + kc; \
        float run_ = pre, eip_ = 0.f; \
        _Pragma("unroll") for (int j = 0; j < 16; ++j) { \
            run_ += (float)lfv[j]; \
            const float d = fminf(fmaxf(run_, -86.f), 86.f);                      \
            const float e = __builtin_amdgcn_exp2f(d), ei = __builtin_amdgcn_rcpf(e); \
            const float fj = (j == 0) ? __builtin_amdgcn_exp2f((float)lfv[0]) : e * eip_;        \
            eip_ = ei; \
            const float qm = bf2f(qv[j]) * e, km = (1.0f - fj) * ei; \
            const int r = sg * 16 + j; \
            Qm_[r * 136 + kc] = (bf16_t)(cvt_pk_bf16(qm, 0.f) & 0xffffu); Km_[r * 136 + kc] = (bf16_t)(cvt_pk_bf16(km, 0.f) & 0xffffu); \
            if (sgi) qbp[j * rstep] = (bf16_t)(cvt_pk_bf16(qm * ek, 0.f) & 0xffffu); \
        } \
        btot += bend; \
        if (sg == 0) { HG_EMID(bf_)[kc] = __builtin_amdgcn_exp2f(bmid); HG_E2(bf_)[kc] = __builtin_amdgcn_exp2f(bend - bmid); } \
        _Pragma("unroll") for (int e = 0; e < 2; ++e) { const int c_ = tid + 512 * e; *(LAS u32x4*)(Vs_ + (c_ >> 4) * 136 + (c_ & 15) * 8) = rv[e]; } \
        if ((cidx) + 1 < c1) HG_PREFETCH((cidx) + 1); \
    } while (0)
#define HG_COMP_C(bf_) do { \
        const LAS bf16_t* Qm_ = HG_QM(bf_); const LAS bf16_t* Km_ = HG_KM(bf_); const LAS float* em_ = HG_EMID(bf_); \
        { const int tt = w >> 1; \
          f32x4 sc0 = (f32x4){0.f, 0.f, 0.f, 0.f}, sc1 = sc0; \
          const LAS bf16_t* qa = Qm_ + (16 * tt + l15) * 136 + 8 * q4; \
          const LAS bf16_t* kb = Km_ + (32 * (w & 1) + l15) * 136 + 8 * q4; \
          _Pragma("unroll") for (int ks = 0; ks < 4; ++ks) { \
              const bf16x8 a = *(const LAS bf16x8*)(qa + 32 * ks); \
              sc0 = __builtin_amdgcn_mfma_f32_16x16x32_bf16(a, *(const LAS bf16x8*)(kb + 32 * ks), sc0, 0, 0, 0); \
              sc1 = __builtin_amdgcn_mfma_f32_16x16x32_bf16(a, *(const LAS bf16x8*)(kb + 16 * 136 + 32 * ks), sc1, 0, 0, 0); } \
          _Pragma("unroll") for (int r = 0; r < 4; ++r) { \
              const int t = 16 * tt + 4 * q4 + r, s_0 = 32 * (w & 1) + l15, s_1 = s_0 + 16; \
              Ps[t * 72 + s_0] = (bf16_t)(cvt_pk_bf16(s_0 <= t ? sc0[r] : 0.f, 0.f) & 0xffffu); \
              Ps[t * 72 + s_1] = (bf16_t)(cvt_pk_bf16(s_1 <= t ? sc1[r] : 0.f, 0.f) & 0xffffu); } } \
        _Pragma("unroll") for (int i = 0; i < 4; ++i) oacc[i] = (f32x4){0.f, 0.f, 0.f, 0.f}; \
        _Pragma("unroll") for (int i = 0; i < 4; ++i) { \
            S[2 * i] = S[2 * i] * *(const LAS f32x4*)(em_ + 32 * i + 4 * q4); S[2 * i + 1] = S[2 * i + 1] * *(const LAS f32x4*)(em_ + 32 * i + 16 + 4 * q4); \
            u32x4 bw; bw.x = cvt_pk_bf16(S[2 * i][0], S[2 * i][1]); bw.y = cvt_pk_bf16(S[2 * i][2], S[2 * i][3]); bw.z = cvt_pk_bf16(S[2 * i + 1][0], S[2 * i + 1][1]); bw.w = cvt_pk_bf16(S[2 * i + 1][2], S[2 * i + 1][3]); \
            const bf16x8 sb = __builtin_bit_cast(bf16x8, bw); \
            _Pragma("unroll") for (int tt = 0; tt < 4; ++tt) { \
                const LAS bf16_t* qa = Qm_ + (16 * tt + l15) * 136 + 32 * i + 4 * q4; \
                const u32x2 lo = *(const LAS u32x2*)qa, hi = *(const LAS u32x2*)(qa + 16); \
                u32x4 aw; aw.x = lo.x; aw.y = lo.y; aw.z = hi.x; aw.w = hi.y; \
                oacc[tt] = __builtin_amdgcn_mfma_f32_16x16x32_bf16(__builtin_bit_cast(bf16x8, aw), sb, oacc[tt], 0, 0, 0); } } \
    } while (0)
#define HG_COMP_D(cidx, bf_) do { \
        const LAS bf16_t* Km_ = HG_KM(bf_); const LAS bf16_t* Vs_ = HG_VS(bf_); const LAS float* e2_ = HG_E2(bf_); \
        bf16x8 vb[2]; \
        _Pragma("unroll") for (int i = 0; i < 2; ++i) { \
            const LAS bf16_t* va = Vs_ + (32 * i + 8 * q4 + (l15 >> 2)) * 136 + 16 * w + 4 * (l15 & 3); \
            vb[i] = cat44(lds_tr(va), lds_tr(va + 4 * 136)); } \
        _Pragma("unroll") for (int tt = 0; tt < 4; ++tt) \
            _Pragma("unroll") for (int i = 0; i < 2; ++i) { \
                if (32 * i > 16 * tt + 15) continue; \
                const bf16x8 pa = *(const LAS bf16x8*)(Ps + (16 * tt + l15) * 72 + 32 * i + 8 * q4); \
                oacc[tt] = __builtin_amdgcn_mfma_f32_16x16x32_bf16(pa, vb[i], oacc[tt], 0, 0, 0); } \
        bf16_t* op = O + HG_ROW((cidx) * 64 + 4 * q4) * 512 + hc + 16 * w + l15; \
        _Pragma("unroll") for (int tt = 0; tt < 4; ++tt) \
            _Pragma("unroll") for (int r = 0; r < 4; ++r) op[(16 * tt + r) * rstep] = (bf16_t)(cvt_pk_bf16(oacc[tt][r], 0.f) & 0xffffu); \
        _Pragma("unroll") for (int kt = 0; kt < 8; ++kt) { \
            _Pragma("unroll") for (int i = 0; i < 2; ++i) { \
                const LAS bf16_t* ka = Km_ + (32 * i + 8 * q4 + (l15 >> 2)) * 136 + 16 * kt + 4 * (l15 & 3); \
                S[kt] = __builtin_amdgcn_mfma_f32_16x16x32_bf16(cat44(lds_tr(ka), lds_tr(ka + 4 * 136)), vb[i], S[kt], 0, 0, 0); } \
            S[kt] = S[kt] * *(const LAS f32x4*)(e2_ + 16 * kt + 4 * q4); } \
    } while (0)
    HG_PREFETCH(c0);
    HG_PREP_A();
    __syncthreads();
    HG_PREP_B(c0, 0);
    __syncthreads();
    HG_PREP_A();
    __syncthreads();
    for (int ci = c0; ci < c1; ++ci) {
        const int bf = (ci - c0) & 1;
        const bool more = ci + 1 < c1, more2 = ci + 2 < c1;
        if (bf == 0) { if (more) HG_PREP_B(ci + 1, 1); HG_COMP_C(0); } else { if (more) HG_PREP_B(ci + 1, 0); HG_COMP_C(1); }
        __syncthreads();
        if (bf == 0) HG_COMP_D(ci, 0); else HG_COMP_D(ci, 1);
        if (more2) HG_PREP_A();
        __syncthreads();
    }
#undef HG_PREP_A
#undef HG_PREP_B
#undef HG_COMP_C
#undef HG_COMP_D
#undef HG_QM
#undef HG_KM
#undef HG_VS
#undef HG_EMID
#undef HG_E2
    if (sgi == 0) {
#pragma unroll
        for (int kt = 0; kt < 8; ++kt) *(f32x4*)(SM + ((size_t)chain * 128 + 16 * w + l15) * 128 + 16 * kt + 4 * q4) = S[kt];
    }
#undef HG_PREFETCH
}

__device__ __forceinline__ void hgrn_carry_item(const Params& p, int item, LAS unsigned char* lds, int& staged_chain) {
    const int tid = threadIdx.x, lane = tid & 63, w = tid >> 6, l15 = lane & 15, q4 = lane >> 4;
    const int tile = item & 15, chain = item >> 4, dir = chain & 1, h = (chain >> 1) & 3, b = chain >> 3;
    unsigned char* ws = p.ws;
    const bf16_t* QB = (const bf16_t*)(ws + O_QB); const float* SM = (const float*)(ws + O_SMID);
    bf16_t* O = (bf16_t*)(ws + (dir ? O_OB : O_OF));
    LAS bf16_t* Sm = (LAS bf16_t*)lds;
    if (staged_chain != chain) {
        __syncthreads();
        const int v = tid >> 2, kq = (tid & 3) * 32;
        const float* sp = SM + ((size_t)chain * 128 + v) * 128 + kq;
        f32x4 t[8];
#pragma unroll
        for (int e = 0; e < 8; ++e) t[e] = *(const f32x4*)(sp + 4 * e);
#pragma unroll
        for (int e = 0; e < 4; ++e) { const u32x2 lo = pack4(t[2 * e]), hi = pack4(t[2 * e + 1]); *(LAS u32x4*)(Sm + v * 136 + kq + 8 * e) = (u32x4){lo.x, lo.y, hi.x, hi.y}; }
        __syncthreads();
        staged_chain = chain;
    }
    const size_t rb = (size_t)b * SEQ; const int hc = h * 128;
    const int g0 = SEQ / 2 + tile * 128 + w * 16;
    bf16x8 qa[4];
#pragma unroll
    for (int ks = 0; ks < 4; ++ks) qa[ks] = *(const bf16x8*)(QB + HG_ROW(g0 + l15) * 512 + hc + 32 * ks + 8 * q4);
#pragma unroll
    for (int vt = 0; vt < 8; ++vt) {
        f32x4 acc = (f32x4){0.f, 0.f, 0.f, 0.f};
        const LAS bf16_t* sp = Sm + (16 * vt + l15) * 136 + 8 * q4;
#pragma unroll
        for (int ks = 0; ks < 4; ++ks) acc = __builtin_amdgcn_mfma_f32_16x16x32_bf16(qa[ks], *(const LAS bf16x8*)(sp + 32 * ks), acc, 0, 0, 0);
#pragma unroll
        for (int r = 0; r < 4; ++r) {
            bf16_t* op = O + HG_ROW(g0 + 4 * q4 + r) * 512 + hc + 16 * vt + l15;
            *op = (bf16_t)(cvt_pk_bf16(bf2f(*op) + acc[r], 0.f) & 0xffffu);
        }
    }
}
#undef HG_ROW

__device__ __forceinline__ void wattn_item(const Params& p, int item, LAS unsigned char* lds) {
    const int tid = threadIdx.x, lane = tid & 63, w = tid >> 6, l15 = lane & 15, q4 = lane >> 4;
    const int qh = item & 7, nb = (item >> 3) & 31, b = item >> 8, hk = qh >> 2;
    unsigned char* ws = p.ws;
    const bf16_t* QA = (const bf16_t*)(ws + O_QA); const bf16_t* KA = (const bf16_t*)(ws + O_KA); const bf16_t* VA = (const bf16_t*)(ws + O_VA);
    bf16_t* OA = (bf16_t*)(ws + O_OA);
    LAS bf16_t* Ks = (LAS bf16_t*)lds; LAS bf16_t* Vs = Ks + 400 * 72;
    {
        u32x4 sk[7], sv[7];
#pragma unroll
        for (int e = 0; e < 7; ++e) {
            const int r = (tid >> 3) + 64 * e, ch = (tid & 7) * 8; const int tok = (nb - 1) * 128 + r;
            sk[e] = (u32x4){0u, 0u, 0u, 0u}; sv[e] = sk[e];
            if (r < 384 && tok >= 0 && tok < SEQ) { const size_t row = (size_t)b * SEQ + tok; sk[e] = *(const u32x4*)(KA + row * 128 + hk * 64 + ch); sv[e] = *(const u32x4*)(VA + row * 128 + hk * 64 + ch); }
        }
#pragma unroll
        for (int e = 0; e < 7; ++e) {
            const int r = (tid >> 3) + 64 * e, ch = (tid & 7) * 8;
            if (r < 400) { *(LAS u32x4*)(Ks + r * 72 + ch) = sk[e]; *(LAS u32x4*)(Vs + r * 72 + ch) = sv[e]; }
        }
    }
    __syncthreads();
    const size_t qrow = (size_t)b * SEQ + nb * 128 + w * 16 + l15;
    const bf16x8 bq0 = *(const bf16x8*)(QA + qrow * 512 + qh * 64 + 8 * q4), bq1 = *(const bf16x8*)(QA + qrow * 512 + qh * 64 + 32 + 8 * q4);
    f32x4 sc[18];
#pragma unroll
    for (int s = 0; s < 18; ++s) {
        const LAS bf16_t* kr = Ks + (16 * (w + s) + l15) * 72 + 8 * q4;
        const bf16x8 a0 = *(const LAS bf16x8*)kr, a1 = *(const LAS bf16x8*)(kr + 32);
        f32x4 z = (f32x4){0.f, 0.f, 0.f, 0.f};
        z = __builtin_amdgcn_mfma_f32_16x16x32_bf16(a0, bq0, z, 0, 0, 0);
        sc[s] = __builtin_amdgcn_mfma_f32_16x16x32_bf16(a1, bq1, z, 0, 0, 0);
        if ((s & 3) == 3) __builtin_amdgcn_sched_barrier(0);
    }
    const int tq = 16 * w + l15;
    const int lo = max(tq, (1 - nb) * 128), hi = min(tq + 256, SEQ - 1 - (nb - 1) * 128);
    const int sl0 = 16 * w + 4 * q4;
    float mx = -1e30f;
#pragma unroll
    for (int s = 0; s < 18; ++s)
#pragma unroll
        for (int r = 0; r < 4; ++r) {
            const int sl = sl0 + 16 * s + r;
            const int neg = ((sl - lo) | (hi - sl)) >> 31;
            const float v = sc[s][r] + __uint_as_float((unsigned)neg & 0xF149F2CAu);
            sc[s][r] = v; mx = fmaxf(mx, v);
        }
    mx = fmaxf(mx, __shfl_xor(mx, 16)); mx = fmaxf(mx, __shfl_xor(mx, 32));
    const float sk = p.sink[qh]; mx = fmaxf(mx, sk);
    float sum = 0.f;
#pragma unroll
    for (int s = 0; s < 18; ++s)
#pragma unroll
        for (int r = 0; r < 4; ++r) { const float e = __expf(sc[s][r] - mx); sc[s][r] = e; sum += e; }
    sum += __shfl_xor(sum, 16); sum += __shfl_xor(sum, 32);
    sum += __expf(sk - mx);
    const float inv = 1.0f / sum;
    f32x4 oc[4];
#pragma unroll
    for (int d = 0; d < 4; ++d) oc[d] = (f32x4){0.f, 0.f, 0.f, 0.f};
#pragma unroll
    for (int i = 0; i < 9; ++i) {
        u32x4 pw; pw.x = cvt_pk_bf16(sc[2 * i][0] * inv, sc[2 * i][1] * inv); pw.y = cvt_pk_bf16(sc[2 * i][2] * inv, sc[2 * i][3] * inv);
        pw.z = cvt_pk_bf16(sc[2 * i + 1][0] * inv, sc[2 * i + 1][1] * inv); pw.w = cvt_pk_bf16(sc[2 * i + 1][2] * inv, sc[2 * i + 1][3] * inv);
        const bf16x8 pa = __builtin_bit_cast(bf16x8, pw);
        const LAS bf16_t* vb = Vs + (16 * (w + 2 * i) + 4 * q4 + (l15 >> 2)) * 72 + 4 * (l15 & 3);
#pragma unroll
        for (int d = 0; d < 4; ++d) {
            const s16x4 v0 = lds_tr(vb + 16 * d), v1 = lds_tr(vb + 16 * 72 + 16 * d);
            bf16x8 bv; bv[0] = v0[0]; bv[1] = v0[1]; bv[2] = v0[2]; bv[3] = v0[3]; bv[4] = v1[0]; bv[5] = v1[1]; bv[6] = v1[2]; bv[7] = v1[3];
            oc[d] = __builtin_amdgcn_mfma_f32_16x16x32_bf16(pa, bv, oc[d], 0, 0, 0);
        }
        __builtin_amdgcn_sched_barrier(0);
    }
    const size_t orow = (size_t)b * SEQ + nb * 128 + w * 16 + 4 * q4;
#pragma unroll
    for (int d = 0; d < 4; ++d)
#pragma unroll
        for (int r = 0; r < 4; ++r) OA[(orow + r) * 1024 + 512 + qh * 64 + 16 * d + l15] = (bf16_t)(cvt_pk_bf16(oc[d][r], 0.f) & 0xffffu);
    __syncthreads();
}

__device__ __forceinline__ void hgrn_combine_row(const Params& p, int row, int lane) {
    unsigned char* ws = p.ws;
    const u32x4 a = *(const u32x4*)((const bf16_t*)(ws + O_OF) + (size_t)row * 512 + lane * 8), c = *(const u32x4*)((const bf16_t*)(ws + O_OB) + (size_t)row * 512 + lane * 8);
    const u32x4 g = *(const u32x4*)((const bf16_t*)(ws + O_SG) + (size_t)row * 512 + lane * 8);
    float o[8];
    o[0] = bflo(a.x) + bflo(c.x); o[1] = bfhi(a.x) + bfhi(c.x); o[2] = bflo(a.y) + bflo(c.y); o[3] = bfhi(a.y) + bfhi(c.y);
    o[4] = bflo(a.z) + bflo(c.z); o[5] = bfhi(a.z) + bfhi(c.z); o[6] = bflo(a.w) + bflo(c.w); o[7] = bfhi(a.w) + bfhi(c.w);
    float ss = 0.f;
#pragma unroll
    for (int i = 0; i < 8; ++i) ss += o[i] * o[i];
    ss += __shfl_xor(ss, 1); ss += __shfl_xor(ss, 2); ss += __shfl_xor(ss, 4); ss += __shfl_xor(ss, 8);
    const float rs = rsqrtf(ss * (1.0f / 128.0f) + 1e-6f);
    const f32x4 n0 = *(const f32x4*)(p.hg_norm + lane * 8), n1 = *(const f32x4*)(p.hg_norm + lane * 8 + 4);
    u32x4 w;
    w.x = cvt_pk_bf16(o[0] * rs * n0[0] * bflo(g.x), o[1] * rs * n0[1] * bfhi(g.x)); w.y = cvt_pk_bf16(o[2] * rs * n0[2] * bflo(g.y), o[3] * rs * n0[3] * bfhi(g.y));
    w.z = cvt_pk_bf16(o[4] * rs * n1[0] * bflo(g.z), o[5] * rs * n1[1] * bfhi(g.z)); w.w = cvt_pk_bf16(o[6] * rs * n1[2] * bflo(g.w), o[7] * rs * n1[3] * bfhi(g.w));
    *(u32x4*)((bf16_t*)(ws + O_OA) + (size_t)row * 1024 + lane * 8) = w;
}

__device__ __forceinline__ void mattn_item(const Params& p, int item, LAS unsigned char* lds) {
    const int tid = threadIdx.x, lane = tid & 63, w = tid >> 6, l15 = lane & 15, q4 = lane >> 4;
    const int qt = item & 31, hd = (item >> 5) & 3, b = item >> 7;
    unsigned char* ws = p.ws;
    const bf16_t* QM = (const bf16_t*)(ws + O_QM); const bf16_t* KVM = (const bf16_t*)(ws + O_KVM); bf16_t* OM = (bf16_t*)(ws + O_OM);
    LAS bf16_t* Ks = (LAS bf16_t*)lds;
#pragma unroll
    for (int hf = 0; hf < 2; ++hf) {
        u32x4 st[8];
#pragma unroll
        for (int e = 0; e < 8; ++e) st[e] = *(const u32x4*)(KVM + (size_t)(b * 256 + (tid >> 5) + 16 * (8 * hf + e)) * 2048 +  hd * 256 + (tid & 31) * 8);
#pragma unroll
        for (int e = 0; e < 8; ++e) *(LAS u32x4*)(Ks + ((tid >> 5) + 16 * (8 * hf + e)) * 264 + (tid & 31) * 8) = st[e];
    }
    __syncthreads();
    const size_t qrow = (size_t)b * SEQ + qt * 128 + w * 16 + l15;
    float rsq;
    { const f32x4* q_ = (const f32x4*)((const float*)(ws + O_SSP2) + qrow * 16); const f32x4 t_ = (q_[0] + q_[1]) + (q_[2] + q_[3]); rsq = rsqrtf(((t_[0] + t_[1]) + (t_[2] + t_[3])) * (1.0f / 1024.0f) + 1e-6f); }
    bf16x8 bq[8];
#pragma unroll
    for (int d = 0; d < 8; ++d) bq[d] = *(const bf16x8*)(QM + qrow * 1024 + hd * 256 + d * 32 + 8 * q4);
    f32x4 sc[16];
#pragma unroll
    for (int s = 0; s < 16; ++s) {
        const LAS bf16_t* kr = Ks + (16 * s + l15) * 264 + 8 * q4;
        f32x4 z = (f32x4){0.f, 0.f, 0.f, 0.f};
#pragma unroll
        for (int d = 0; d < 8; ++d) z = __builtin_amdgcn_mfma_f32_16x16x32_bf16(*(const LAS bf16x8*)(kr + 32 * d), bq[d], z, 0, 0, 0);
        sc[s] = z;
        if (s & 1) __builtin_amdgcn_sched_barrier(0);
    }
    float mx = -1e30f;
#pragma unroll
    for (int s = 0; s < 16; ++s)
#pragma unroll
        for (int r = 0; r < 4; ++r) mx = fmaxf(mx, sc[s][r]);
    mx = fmaxf(mx, __shfl_xor(mx, 16)); mx = fmaxf(mx, __shfl_xor(mx, 32));
    float sum = 0.f;
#pragma unroll
    for (int s = 0; s < 16; ++s)
#pragma unroll
        for (int r = 0; r < 4; ++r) { const float e = __expf((sc[s][r] - mx) * rsq); sc[s][r] = e; sum += e; }
    sum += __shfl_xor(sum, 16); sum += __shfl_xor(sum, 32);
    const float inv = 1.0f / sum;
    bf16x8 pa[8];
#pragma unroll
    for (int i = 0; i < 8; ++i) {
        u32x4 pw; pw.x = cvt_pk_bf16(sc[2 * i][0] * inv, sc[2 * i][1] * inv); pw.y = cvt_pk_bf16(sc[2 * i][2] * inv, sc[2 * i][3] * inv);
        pw.z = cvt_pk_bf16(sc[2 * i + 1][0] * inv, sc[2 * i + 1][1] * inv); pw.w = cvt_pk_bf16(sc[2 * i + 1][2] * inv, sc[2 * i + 1][3] * inv);
        pa[i] = __builtin_bit_cast(bf16x8, pw);
    }
    __syncthreads();
#pragma unroll
    for (int hf = 0; hf < 2; ++hf) {
        u32x4 st[8];
#pragma unroll
        for (int e = 0; e < 8; ++e) st[e] = *(const u32x4*)(KVM + (size_t)(b * 256 + (tid >> 5) + 16 * (8 * hf + e)) * 2048 + 1024 + hd * 256 + (tid & 31) * 8);
#pragma unroll
        for (int e = 0; e < 8; ++e) *(LAS u32x4*)(Ks + ((tid >> 5) + 16 * (8 * hf + e)) * 264 + (tid & 31) * 8) = st[e];
    }
    __syncthreads();
    const size_t orow = (size_t)b * SEQ + qt * 128 + w * 16 + 4 * q4;
#pragma unroll
    for (int dh = 0; dh < 2; ++dh) {
        f32x4 oc[8];
#pragma unroll
        for (int d = 0; d < 8; ++d) oc[d] = (f32x4){0.f, 0.f, 0.f, 0.f};
#pragma unroll
        for (int i = 0; i < 8; ++i) {
            const LAS bf16_t* vb = Ks + (32 * i + 4 * q4 + (l15 >> 2)) * 264 + dh * 128 + 4 * (l15 & 3);
#pragma unroll
            for (int d = 0; d < 8; ++d) {
                const s16x4 v0 = lds_tr(vb + 16 * d), v1 = lds_tr(vb + 16 * 264 + 16 * d);
                bf16x8 bv; bv[0] = v0[0]; bv[1] = v0[1]; bv[2] = v0[2]; bv[3] = v0[3]; bv[4] = v1[0]; bv[5] = v1[1]; bv[6] = v1[2]; bv[7] = v1[3];
                oc[d] = __builtin_amdgcn_mfma_f32_16x16x32_bf16(pa[i], bv, oc[d], 0, 0, 0);
            }
            __builtin_amdgcn_sched_barrier(0);
        }
#pragma unroll
        for (int d = 0; d < 8; ++d)
#pragma unroll
            for (int r = 0; r < 4; ++r) OM[(orow + r) * 1024 + hd * 256 + dh * 128 + 16 * d + l15] = (bf16_t)(cvt_pk_bf16(oc[d][r], 0.f) & 0xffffu);
    }
    __syncthreads();
}

#ifndef DBG
#define DBG 0
#endif
#ifndef STOP_AFTER
#define STOP_AFTER 99
#endif
#define XB_TMO      128
#define XB_XCNT(j)  (256  + 64 * (j))
#define XB_XSUB(j)  (1280 + 64 * (j))
#define XB_XGEN(j)  (2304 + 64 * (j))
#define XB_TOP      3328
#define XB_TOPGEN   3392
#define XCD_BAR_WORDS 3456
#define XB_SPIN_CAP (1u << 18)

__device__ __forceinline__ unsigned xb_ld(unsigned* p)              { return __hip_atomic_load(p, __ATOMIC_RELAXED, __HIP_MEMORY_SCOPE_AGENT); }
__device__ __forceinline__ unsigned xb_add(unsigned* p, unsigned v) { return __hip_atomic_fetch_add(p, v, __ATOMIC_RELAXED, __HIP_MEMORY_SCOPE_AGENT); }
__device__ __forceinline__ unsigned xb_xcc_id() { return (unsigned)__builtin_amdgcn_s_getreg((3 << 11) | 20) & 0xFu; }
#define XB_SPIN(cond, bar) do { unsigned _sp = 0; while (cond) { __builtin_amdgcn_s_sleep(1); \
    if ((++_sp & 255u) == 0u) { if (xb_ld(&(bar)[XB_TMO])) break; if (_sp > XB_SPIN_CAP) { atomicAdd(&(bar)[XB_TMO], 1u); break; } } } } while (0)

struct XcdBarrier {
    unsigned* bar; unsigned x;
    volatile LAS unsigned* st;
};

__device__ __forceinline__ XcdBarrier xcd_barrier_post(unsigned* bar, volatile LAS unsigned* st) {
    XcdBarrier b; b.bar = bar; b.x = xb_xcc_id(); b.st = st;
    if (threadIdx.x == 0) (void)xb_add(&bar[XB_XCNT(b.x)], 1u);
    return b;
}
__device__ __forceinline__ void xcd_barrier_complete(unsigned* bar, unsigned x, unsigned& nloc, unsigned& nx) {
    const unsigned G = gridDim.x * gridDim.y * gridDim.z;
    unsigned sum, cnt, mine, sp = 0u;
    for (;;) {
        sum = 0u; cnt = 0u; mine = 0u;
#pragma unroll
        for (unsigned j = 0; j < 16; ++j) { const unsigned c = xb_ld(&bar[XB_XCNT(j)]); sum += c; cnt += (c > 0u) ? 1u : 0u; mine = (j == x) ? c : mine; }
        if (sum == G) break;
        __builtin_amdgcn_s_sleep(1);
        if ((++sp & 255u) == 0u) { if (xb_ld(&bar[XB_TMO])) break; if (sp > XB_SPIN_CAP) { atomicAdd(&bar[XB_TMO], 1u); break; } }
    }
    nloc = mine > 0u ? mine : 1u; nx = cnt > 0u ? cnt : 1u;
}

__device__ __forceinline__ void xcd_barrier(const XcdBarrier& b) {
    asm volatile("s_waitcnt vmcnt(0)" ::: "memory");
    __syncthreads();
    if (threadIdx.x == 0) {
        unsigned* bar = b.bar;
        __builtin_amdgcn_s_waitcnt(0);
        unsigned nloc = b.st[0], nx = b.st[1];
        if (nloc == 0u) { xcd_barrier_complete(bar, b.x, nloc, nx); b.st[0] = nloc; b.st[1] = nx; }
        const unsigned old = xb_add(&bar[XB_XSUB(b.x)], 1u);
        const unsigned gen = old / nloc;
        if (old + 1u == (gen + 1u) * nloc) {
            __builtin_amdgcn_fence(__ATOMIC_RELEASE, "agent");
            asm volatile("s_waitcnt vmcnt(0)" ::: "memory");
            const unsigned og = xb_add(&bar[XB_TOP], 1u);
            const unsigned tg = og / nx;
            if (og + 1u == (tg + 1u) * nx) xb_add(&bar[XB_TOPGEN], 1u);
            else XB_SPIN(xb_ld(&bar[XB_TOPGEN]) == tg, bar);
            __builtin_amdgcn_fence(__ATOMIC_ACQUIRE, "agent");
            xb_add(&bar[XB_XGEN(b.x)], 1u);
            asm volatile("s_waitcnt vmcnt(0)" ::: "memory");
        } else {
            XB_SPIN(xb_ld(&bar[XB_XGEN(b.x)]) == gen, bar);
            __builtin_amdgcn_fence(__ATOMIC_ACQUIRE, "agent");
            asm volatile("s_waitcnt vmcnt(0)" ::: "memory");
        }
    }
    __syncthreads();
}

#define GRID_SYNC() xcd_barrier(xb)
__global__ void __launch_bounds__(512) mk_kernel(Params p) {
    cg::grid_group grid = cg::this_grid();
    extern __shared__ __attribute__((aligned(16))) unsigned char lds_raw[];
    LAS unsigned char* lds = (LAS unsigned char*)lds_raw;
    unsigned char* ws = p.ws;
    const int tid = threadIdx.x, lane = tid & 63, w = tid >> 6;
    const int G = gridDim.x, c = blockIdx.x;

    volatile LAS unsigned* xst = (volatile LAS unsigned*)(lds + 143344);
    if (tid == 0) { xst[0] = 0u; xst[1] = 0u; }
    __syncthreads();
    const XcdBarrier xb = xcd_barrier_post((unsigned*)(ws + O_BAR), xst);
    if (p.njobs < 0) grid.sync();
    phase_prep(p, lds, 0, p.jobs[2].tile0, true, c, G);
    GRID_SYNC();

    {
        pg8::StaticOrder S; S.init(T, 5376, G, c);
        EpiProj E; E.rstd = (const float*)(ws + O_RSTD1); E.lbt = (const float*)(ws + O_LBT); E.cs = (const float*)(ws + O_CS);
        E.QH = (bf16_t*)(ws + O_QH); E.VH = (bf16_t*)(ws + O_VH); E.SG = (bf16_t*)(ws + O_SG); E.QA = (bf16_t*)(ws + O_QA); E.KA = (bf16_t*)(ws + O_KA); E.VA = (bf16_t*)(ws + O_VA);
        E.GR = (bf16_t*)p.out; E.GA = (bf16_t*)p.out + (size_t)T * 1024; E.KKF = (_Float16*)(ws + O_KKF); E.KKB = (_Float16*)(ws + O_KKB);
        pg8::gemm_phase(lds, pg8::Gemm{(const bf16_t*)(ws + O_XB), (const bf16_t*)(ws + O_WIN), T, 5376, 1024, 1024, 1024}, S, E);
        pg8::StaticOrder S2; S2.init(2048, 2048, G, G - 1 - c);
        EpiScale<2> E2; E2.rs = nullptr; E2.O = (bf16_t*)(ws + O_KVM); E2.ldo = 2048; E2.O2 = E2.O; E2.split = 1 << 30;
        pg8::gemm_phase(lds, pg8::Gemm{(const bf16_t*)(ws + O_MEMB), (const bf16_t*)(ws + O_WMKV), 2048, 2048, 1024, 1024, 1024}, S2, E2);
    }
    GRID_SYNC();

    if (DBG == 1) {
        const unsigned short* a0 = (const unsigned short*)(ws + O_QH); const unsigned short* a1 = (const unsigned short*)(ws + O_KKF); const unsigned short* a2 = (const unsigned short*)(ws + O_KKB);
        const unsigned short* a3 = (const unsigned short*)(ws + O_VH); const unsigned short* a4 = (const unsigned short*)(ws + O_SG); const unsigned short* a5 = (const unsigned short*)(ws + O_QA);
        const unsigned short* a6 = (const unsigned short*)(ws + O_KA); const unsigned short* a7 = (const unsigned short*)(ws + O_VA);
        for (size_t idx = (size_t)blockIdx.x * 512 + threadIdx.x; idx < (size_t)T * 1024; idx += (size_t)gridDim.x * 512) {
            const size_t row = idx >> 10; const int c = (int)(idx & 1023), c5 = c & 511, c1 = c & 127; float v;
            if (c < 512) v = bf2f(a0[row * 512 + c5]) + bf2f(a1[row * 512 + c5]) * 0.001f + bf2f(a2[row * 512 + c5]) * 0.001f + bf2f(a3[row * 512 + c5]);
            else v = bf2f(a4[row * 512 + c5]) + bf2f(a5[row * 512 + c5]) + bf2f(a6[row * 128 + c1]) + bf2f(a7[row * 128 + c1]);
            p.out[idx] = v;
        }
        return;
    }
    {
        const int nh = G >= 256 ? 128 : 0;
        if (c < nh || nh == 0) for (int it = c; it < 128; it += (nh ? nh : G)) hgrn_item(p, it, lds);
        if (c >= nh) phase_prep(p, lds, p.jobs[2].tile0, p.ntiles, false, c - nh, G - nh);
        {
            unsigned* qctr = (unsigned*)(ws + O_BAR);
            volatile LAS unsigned* qslot = (volatile LAS unsigned*)(lds + 143352);
            for (;;) {
                __syncthreads();
                if (tid == 0) *qslot = __hip_atomic_fetch_add(qctr, 1u, __ATOMIC_RELAXED, __HIP_MEMORY_SCOPE_AGENT);
                __syncthreads();
                const unsigned it = *qslot;
                if (it >= 2048u) break;
                wattn_item(p, (int)it, lds);
            }
        }
    }
    GRID_SYNC();
    {
        const int per = (1024 + G - 1) / G; int staged = -1;
        for (int it = c * per; it < (c + 1) * per && it < 1024; ++it) hgrn_carry_item(p, it, lds, staged);
        __syncthreads();
    }
    GRID_SYNC();
    for (int r = c * 8 + w; r < T; r += G * 8) hgrn_combine_row(p, r, lane);
    GRID_SYNC();

    if (DBG == 2) {
        const unsigned short* a0 = (const unsigned short*)(ws + O_OA);
        for (size_t idx = (size_t)blockIdx.x * 512 + threadIdx.x; idx < (size_t)T * 1024; idx += (size_t)gridDim.x * 512) p.out[idx] = bf2f(a0[idx]);
        return;
    }
    {
        pg8::StaticOrder S; S.init(T, 1024, G, c);
        EpiMergeFused E; E.GR = (const bf16_t*)p.out; E.GA = (const bf16_t*)p.out + (size_t)T * 1024; E.O = (bf16_t*)(ws + O_MERGED);
        pg8::gemm_phase(lds, pg8::Gemm{(const bf16_t*)(ws + O_OA), (const bf16_t*)(ws + O_WMID), T, 1024, 1024, 1024, 1024}, S, E);
    }
    GRID_SYNC();
    if (DBG == 3) {
        const unsigned short* a0 = (const unsigned short*)(ws + O_MERGED);
        for (size_t idx = (size_t)blockIdx.x * 512 + threadIdx.x; idx < (size_t)T * 1024; idx += (size_t)gridDim.x * 512) p.out[idx] = bf2f(a0[idx]);
        return;
    }
    {
        pg8::StaticOrder S; S.init(T, 1024, G, c);
        EpiRes<0> E; E.base = p.x; E.HB = (bf16_t*)(ws + O_HB1); E.ssp = (float*)(ws + O_SSP2);
        pg8::gemm_phase(lds, pg8::Gemm{(const bf16_t*)(ws + O_MERGED), (const bf16_t*)(ws + O_WOUT), T, 1024, 1024, 1024, 1024}, S, E);
    }
    GRID_SYNC();
    if (STOP_AFTER == 4) return;
    {
        pg8::StaticOrder S; S.init(T, 1024, G, c);
        EpiScale<2> E; E.rs = nullptr; E.O = (bf16_t*)(ws + O_QM); E.ldo = 1024; E.O2 = E.O; E.split = 1 << 30;
        pg8::gemm_phase(lds, pg8::Gemm{(const bf16_t*)(ws + O_HB1), (const bf16_t*)(ws + O_WMQ), T, 1024, 1024, 1024, 1024}, S, E);
        asm volatile("s_waitcnt vmcnt(0)" ::: "memory");
        __syncthreads();
        __builtin_amdgcn_fence(__ATOMIC_ACQUIRE, "agent");
        pg8::Unit u;
        for (int i = 0; S.next(i, u); ++i)
#pragma nounroll
            for (int hq = 0; hq < 2; ++hq) mattn_item(p, ((u.pm >> 4) << 7) | (u.pn << 5) | (2 * (u.pm & 15) + hq), lds);
    }
    GRID_SYNC();
    {
        pg8::StaticOrder S; S.init(T, 1024, G, c);
        EpiRes<1> E; E.base = ws + O_HB1; E.HB = (bf16_t*)(ws + O_HB2); E.ssp = (float*)(ws + O_SSP3);
        pg8::gemm_phase(lds, pg8::Gemm{(const bf16_t*)(ws + O_OM), (const bf16_t*)(ws + O_WMO), T, 1024, 1024, 1024, 1024}, S, E);
    }
    GRID_SYNC();
    if (STOP_AFTER == 7) return;
    {
        pg8::StaticOrder S; S.init(T, 5632, G, c);
        EpiScale<2> E; E.rs = nullptr; E.O = (bf16_t*)(ws + O_U); E.ldo = 2816; E.O2 = (bf16_t*)(ws + O_G); E.split = 2816;
        pg8::gemm_phase(lds, pg8::Gemm{(const bf16_t*)(ws + O_HB2), (const bf16_t*)(ws + O_WUP), T, 5632, 1024, 1024, 1024}, S, E);
    }
    GRID_SYNC();
    {
        bf16_t* U = (bf16_t*)(ws + O_U); const bf16_t* Gt = (const bf16_t*)(ws + O_G);
        {
            const int ch = (tid < 352 ? tid : 0) * 8;
            f32x4 w0[2], w1[2], w2[2], cb[2];
#pragma unroll
            for (int hh = 0; hh < 2; ++hh) { w0[hh] = *(const f32x4*)(p.conv_w + ch + 4 * hh); w1[hh] = *(const f32x4*)(p.conv_w + 2816 + ch + 4 * hh); w2[hh] = *(const f32x4*)(p.conv_w + 5632 + ch + 4 * hh); cb[hh] = *(const f32x4*)(p.conv_b + ch + 4 * hh); }
            const u32x4 z4 = (u32x4){0u, 0u, 0u, 0u};
            const float* ssp3 = (const float*)(ws + O_SSP3);
#define ROW_RS(r_) ({ const f32x4* q_ = (const f32x4*)(ssp3 + (size_t)(r_) * 16); const f32x4 t_ = (q_[0] + q_[1]) + (q_[2] + q_[3]); rsqrtf(((t_[0] + t_[1]) + (t_[2] + t_[3])) * (1.0f / 1024.0f) + 1e-6f); })
            LAS float* rsl = (LAS float*)lds;
            for (int sgm = c; sgm < T / 128; sgm += G) {
                const int r0 = sgm * 128;
                __syncthreads();
                if (tid < 130) { const int rw = r0 - 1 + tid; rsl[tid] = ROW_RS(rw < 0 ? 0 : (rw < T ? rw : T - 1)); }
                __syncthreads();
                if (tid >= 352) continue;
                float rp = rsl[0], rc = rsl[1];
                u32x4 gp = (r0 & (SEQ - 1)) ? *(const u32x4*)(Gt + (size_t)(r0 - 1) * 2816 + ch) : z4;
                u32x4 gc = *(const u32x4*)(Gt + (size_t)r0 * 2816 + ch);
                for (int rr = 0; rr < 128; rr += 4) {
                    u32x4 gn[4], uu[4];
#pragma unroll
                    for (int k = 0; k < 4; ++k) {
                        const int row = r0 + rr + k;
                        gn[k] = ((row + 1) & (SEQ - 1)) ? __builtin_nontemporal_load((const u32x4*)(Gt + (size_t)(row + 1) * 2816 + ch)) : z4;
                        uu[k] = __builtin_nontemporal_load((const u32x4*)(U + (size_t)row * 2816 + ch));
                    }
                    float rn[4];
#pragma unroll
                    for (int k = 0; k < 4; ++k) rn[k] = rsl[rr + k + 2];
#pragma unroll
                    for (int k = 0; k < 4; ++k) {
                        const int row = r0 + rr + k;
                        const unsigned gpw[4] = {gp.x, gp.y, gp.z, gp.w}, gcw[4] = {gc.x, gc.y, gc.z, gc.w}, gnw[4] = {gn[k].x, gn[k].y, gn[k].z, gn[k].w}, uw[4] = {uu[k].x, uu[k].y, uu[k].z, uu[k].w};
                        unsigned ow[4];
#pragma unroll
                        for (int d = 0; d < 4; ++d) {
                            const int hh = d >> 1, e0 = (d & 1) * 2;
                            const float a0 = bflo(gpw[d]) * rp * w0[hh][e0] + bflo(gcw[d]) * rc * w1[hh][e0] + bflo(gnw[d]) * rn[k] * w2[hh][e0] + cb[hh][e0];
                            const float a1 = bfhi(gpw[d]) * rp * w0[hh][e0 + 1] + bfhi(gcw[d]) * rc * w1[hh][e0 + 1] + bfhi(gnw[d]) * rn[k] * w2[hh][e0 + 1] + cb[hh][e0 + 1];
                            ow[d] = cvt_pk_bf16(a0 * sigmoidf_(a0) * (bflo(uw[d]) * rc), a1 * sigmoidf_(a1) * (bfhi(uw[d]) * rc));
                        }
                        *(u32x4*)(U + (size_t)row * 2816 + ch) = (u32x4){ow[0], ow[1], ow[2], ow[3]};
                        gp = gc; gc = gn[k]; rp = rc; rc = rn[k];
                    }
                }
            }
        }
    }
    GRID_SYNC();
    {
        pg8::StaticOrder S; S.init(T, 1024, G, c);
        EpiRes<1> E; E.base = ws + O_HB2; E.HB = (bf16_t*)(ws + O_HB3); E.ssp = (float*)(ws + O_SSP4);
        pg8::gemm_phase(lds, pg8::Gemm{(const bf16_t*)(ws + O_U), (const bf16_t*)(ws + O_WDN), T, 1024, 2816, 2816, 2816}, S, E);
    }
    GRID_SYNC();
    if (STOP_AFTER == 10) return;
    {
        const bf16_t* HB3 = (const bf16_t*)(ws + O_HB3); const float* ssp = (const float*)(ws + O_SSP4);
        int tid_ = threadIdx.x; asm volatile("" : "+v"(tid_));
        const int lane = tid_ & 63, w = tid_ >> 6;
        for (int r = (c * 8 + w) * 2; r < T; r += G * 16) {
            u32x4 hv[2][2]; float rs[2];
#pragma unroll
            for (int k = 0; k < 2; ++k) {
#pragma unroll
                for (int i = 0; i < 2; ++i) hv[k][i] = *(const u32x4*)(HB3 + (size_t)(r + k) * 1024 + (i * 64 + lane) * 8);
                const f32x4* q = (const f32x4*)(ssp + (size_t)(r + k) * 16); const f32x4 t = (q[0] + q[1]) + (q[2] + q[3]);
                rs[k] = rsqrtf(((t[0] + t[1]) + (t[2] + t[3])) * (1.0f / 1024.0f) + 1e-6f);
            }
#pragma unroll
            for (int k = 0; k < 2; ++k)
#pragma unroll
                for (int i = 0; i < 2; ++i) {
                    const int col = (i * 64 + lane) * 8;
                    const f32x4 g0 = *(const f32x4*)(p.final_norm + col), g1 = *(const f32x4*)(p.final_norm + col + 4);
                    const u32x4 v = hv[k][i];
                    f32x4 o0, o1;
                    o0[0] = bflo(v.x) * rs[k] * g0[0]; o0[1] = bfhi(v.x) * rs[k] * g0[1]; o0[2] = bflo(v.y) * rs[k] * g0[2]; o0[3] = bfhi(v.y) * rs[k] * g0[3];
                    o1[0] = bflo(v.z) * rs[k] * g1[0]; o1[1] = bfhi(v.z) * rs[k] * g1[1]; o1[2] = bflo(v.w) * rs[k] * g1[2]; o1[3] = bfhi(v.w) * rs[k] * g1[3];
                    *(f32x4*)(p.out + (size_t)(r + k) * 1024 + col) = o0; *(f32x4*)(p.out + (size_t)(r + k) * 1024 + col + 4) = o1;
                }
        }
    }
}

extern "C" void kernel_launch(void* const* d_in, const int* in_sizes, int n_in, void* d_out, int out_size, void* d_ws, size_t ws_size,
                              hipStream_t stream) {
    constexpr size_t kDynLds = 143360;
    static int grid_blocks = 0;
    if (!grid_blocks) {
        int dev = 0, cus = 0, per_cu = 0;
        hipGetDevice(&dev);
        hipDeviceGetAttribute(&cus, hipDeviceAttributeMultiprocessorCount, dev);
        hipFuncSetAttribute((const void*)mk_kernel, hipFuncAttributeMaxDynamicSharedMemorySize, (int)kDynLds);
        hipOccupancyMaxActiveBlocksPerMultiprocessor(&per_cu, mk_kernel, 512, kDynLds);
        if (per_cu < 1) per_cu = 1;
        grid_blocks = cus * per_cu;
        if (grid_blocks > 256) grid_blocks = 256;
    }
    Params p; memset(&p, 0, sizeof(p));
    p.x = (const float*)d_in[0]; p.mem = (const float*)d_in[1]; p.positions = (const int*)d_in[2];
    const float* norm_mix = (const float*)d_in[3]; const float* w_in = (const float*)d_in[4];
    p.lower_bounds = (const float*)d_in[5]; p.hg_norm = (const float*)d_in[6]; p.sink = (const float*)d_in[7];
    const float* w_br_rec = (const float*)d_in[8]; const float* w_br_att = (const float*)d_in[9]; const float* w_mix_out = (const float*)d_in[10];
    const float* norm_mem = (const float*)d_in[11]; const float* norm_mem_kv = (const float*)d_in[12];
    const float* w_mem_q = (const float*)d_in[13]; const float* w_mem_kv = (const float*)d_in[14]; const float* w_mem_o = (const float*)d_in[15];
    const float* norm_ffn = (const float*)d_in[16]; const float* w_up = (const float*)d_in[17];
    p.conv_w = (const float*)d_in[18]; p.conv_b = (const float*)d_in[19];
    const float* w_down = (const float*)d_in[20]; p.final_norm = (const float*)d_in[21];
    p.out = (float*)d_out; p.ws = (unsigned char*)d_ws;
    for (int i = 0; i < 8; ++i) p.inv_freq[i] = std::pow(500000.0, -(double)i / 8.0);
    int t0 = 0;
    auto job = [&](int idx, const float* src, const float* gain, size_t off, int K, int N, int ldo, int koff, float scale) {
        TJob& j = p.jobs[idx]; j.src = src; j.gain = gain; j.dst_off = (unsigned long long)off; j.K = K; j.N = N; j.ldo = ldo; j.koff = koff; j.scale = scale; j.tile0 = t0;
        t0 += (K / 64) * (N / 256);
    };
    job(0, w_in, norm_mix, O_WIN, 1024, 5376, 1024, 0, 1.0f);
    job(1, w_mem_kv, norm_mem_kv, O_WMKV, 1024, 2048, 1024, 0, 1.0f);
    job(2, w_up, norm_ffn, O_WUP, 1024, 5632, 1024, 0, 1.0f);
    job(3, w_down, nullptr, O_WDN, 2816, 1024, 2816, 0, 1.0f);
    job(4, w_br_rec, nullptr, O_WMID, 512, 1024, 1024, 0, 1.0f);
    job(5, w_br_att, nullptr, O_WMID, 512, 1024, 1024, 512, 1.0f);
    job(6, w_mix_out, nullptr, O_WOUT, 1024, 1024, 1024, 0, 1.0f);
    job(7, w_mem_q, norm_mem, O_WMQ, 1024, 1024, 1024, 0, 0.0625f);
    job(8, w_mem_o, nullptr, O_WMO, 1024, 1024, 1024, 0, 1.0f);
    p.njobs = 9; p.ntiles = t0;
    hipMemsetAsync((unsigned char*)d_ws + O_BAR, 0, XCD_BAR_WORDS * 4, stream);
    void* args[] = {&p};
    hipError_t e = hipLaunchCooperativeKernel((const void*)mk_kernel, dim3(grid_blocks), dim3(512), args, kDynLds, stream);
    if (e != hipSuccess) fprintf(stderr, "cooperative launch failed: %s (grid %d)\n", hipGetErrorString(e), grid_blocks);
}
```
